# Optimizing an MI355X kernel written in HIP

```python
import math
import jax, jax.numpy as jnp
from jax import lax
import numpy as np

D_MODEL = 2048
BATCH = 2
SEQ = 8192
DEPTH = 4

HEAD_DIM = 128
FOX_HEADS = D_MODEL // (2 * HEAD_DIM)
DIFF_HEADS = D_MODEL // (4 * HEAD_DIM)
FOX_WIDTH = FOX_HEADS * HEAD_DIM
DIFF_QK_WIDTH = 2 * DIFF_HEADS * HEAD_DIM
DIFF_V_WIDTH = DIFF_HEADS * 2 * HEAD_DIM
MIX_WIDTH = FOX_WIDTH + DIFF_V_WIDTH
IN_WIDTH = 3 * FOX_WIDTH + FOX_HEADS + 2 * DIFF_QK_WIDTH + DIFF_V_WIDTH
ROPE_THETA = 500000.0
ROPE_DIM = HEAD_DIM // 4
Q_BLOCK = 128
N_GROUPS = 4
EXPERTS_PER_GROUP = 8
N_EXPERTS = N_GROUPS * EXPERTS_PER_GROUP
TOP_K = 2
D_EXPERT = D_MODEL // 4
DISPATCH_CHUNK = 256
DEEPNORM_ALPHA = (2.0 * DEPTH) ** 0.25
DEEPNORM_BETA = (8.0 * DEPTH) ** -0.25
LN_EPS = 1e-5
RMS_EPS = 1e-5

kernel_name = "fox_diffattn_hiermoe_deepnorm_trunk"


def _layer_norm(x, g, b):
    xf = x.astype(jnp.float32)
    mu = jnp.mean(xf, axis=-1, keepdims=True)
    var = jnp.mean(jnp.square(xf - mu), axis=-1, keepdims=True)
    y = (xf - mu) * lax.rsqrt(var + LN_EPS)
    return (y * g.astype(jnp.float32) + b.astype(jnp.float32)).astype(x.dtype)


def _rms_norm(x, g):
    xf = x.astype(jnp.float32)
    y = xf * lax.rsqrt(jnp.mean(jnp.square(xf), axis=-1, keepdims=True) + RMS_EPS)
    return (y * g.astype(jnp.float32)).astype(x.dtype)


def _rope_tables(seq):
    pos = jnp.arange(seq, dtype=jnp.float32)
    inv_freq = ROPE_THETA ** (-jnp.arange(0, ROPE_DIM, 2, dtype=jnp.float32) / ROPE_DIM)
    ang = pos[:, None] * inv_freq[None, :]
    return jnp.cos(ang), jnp.sin(ang)


def _partial_rope(x, cos, sin):
    xr, xp = x[..., :ROPE_DIM], x[..., ROPE_DIM:]
    x1, x2 = jnp.split(xr, 2, axis=-1)
    c = cos.astype(x.dtype)
    s = sin.astype(x.dtype)
    rot = jnp.concatenate([x1 * c - x2 * s, x2 * c + x1 * s], axis=-1)
    return jnp.concatenate([rot, xp], axis=-1)


def _to_qblocks(a):
    b, h, s = a.shape[:3]
    return jnp.moveaxis(a.reshape(b, h, s // Q_BLOCK, Q_BLOCK, *a.shape[3:]), 2, 0)


def _from_qblocks(o):
    nb, b, h, qb, dv = o.shape
    return jnp.moveaxis(o, 0, 2).reshape(b, h, nb * qb, dv)


def _fox_attention(q, k, v, log_f):
    seq = q.shape[2]
    scale = HEAD_DIM ** -0.5
    cum = jnp.cumsum(log_f, axis=-1)
    kpos = jnp.arange(seq)
    qpos = kpos.reshape(seq // Q_BLOCK, Q_BLOCK)

    def block(args):
        q_b, cum_b, pos_b = args
        s = jnp.einsum('bhqd,bhkd->bhqk', q_b, k).astype(jnp.float32) * scale
        s = s + cum_b[..., :, None] - cum[:, :, None, :]
        s = jnp.where(kpos[None, :] <= pos_b[:, None], s, -jnp.inf)
        p = jax.nn.softmax(s, axis=-1)
        return jnp.einsum('bhqk,bhkd->bhqd', p.astype(v.dtype), v)

    return _from_qblocks(lax.map(block, (_to_qblocks(q), _to_qblocks(cum), qpos)))


def _diff_attention(q1, q2, k1, k2, v, lam):
    seq = q1.shape[2]
    scale = HEAD_DIM ** -0.5
    kpos = jnp.arange(seq)
    qpos = kpos.reshape(seq // Q_BLOCK, Q_BLOCK)

    def block(args):
        q1_b, q2_b, pos_b = args
        mask = kpos[None, :] <= pos_b[:, None]
        s1 = jnp.einsum('bhqd,bhkd->bhqk', q1_b, k1).astype(jnp.float32) * scale
        s2 = jnp.einsum('bhqd,bhkd->bhqk', q2_b, k2).astype(jnp.float32) * scale
        p1 = jax.nn.softmax(jnp.where(mask, s1, -jnp.inf), axis=-1)
        p2 = jax.nn.softmax(jnp.where(mask, s2, -jnp.inf), axis=-1)
        a = p1 - lam * p2
        return jnp.einsum('bhqk,bhkd->bhqd', a.astype(v.dtype), v)

    return _from_qblocks(lax.map(block, (_to_qblocks(q1), _to_qblocks(q2), qpos)))


def _hybrid_mixer(h, w_in, b_f, lam_vecs, subln_g, w_o, cos, sin, lambda_init):
    bsz, seq, _ = h.shape
    proj = h @ w_in
    o1 = FOX_WIDTH
    o2 = o1 + FOX_WIDTH
    o3 = o2 + FOX_WIDTH
    o4 = o3 + FOX_HEADS
    o5 = o4 + DIFF_QK_WIDTH
    o6 = o5 + DIFF_QK_WIDTH
    fq, fk, fv, ff = proj[..., :o1], proj[..., o1:o2], proj[..., o2:o3], proj[..., o3:o4]
    dq, dk, dv = proj[..., o4:o5], proj[..., o5:o6], proj[..., o6:]

    def heads(a, n):
        return a.reshape(bsz, seq, n, -1).transpose(0, 2, 1, 3)

    log_f = jax.nn.log_sigmoid(ff.astype(jnp.float32) + b_f.astype(jnp.float32)).transpose(0, 2, 1)
    fox_out = _fox_attention(heads(fq, FOX_HEADS), heads(fk, FOX_HEADS), heads(fv, FOX_HEADS), log_f)

    dq = dq.reshape(bsz, seq, DIFF_HEADS, 2, HEAD_DIM)
    dk = dk.reshape(bsz, seq, DIFF_HEADS, 2, HEAD_DIM)
    q1 = _partial_rope(dq[:, :, :, 0].transpose(0, 2, 1, 3), cos, sin)
    q2 = _partial_rope(dq[:, :, :, 1].transpose(0, 2, 1, 3), cos, sin)
    k1 = _partial_rope(dk[:, :, :, 0].transpose(0, 2, 1, 3), cos, sin)
    k2 = _partial_rope(dk[:, :, :, 1].transpose(0, 2, 1, 3), cos, sin)
    lv = lam_vecs.astype(jnp.float32)
    lam = jnp.exp(jnp.sum(lv[0] * lv[1])) - jnp.exp(jnp.sum(lv[2] * lv[3])) + lambda_init
    diff_out = _diff_attention(q1, q2, k1, k2, heads(dv, DIFF_HEADS), lam)
    diff_out = _rms_norm(diff_out, subln_g) * (1.0 - lambda_init)

    merged = jnp.concatenate([
        fox_out.transpose(0, 2, 1, 3).reshape(bsz, seq, FOX_WIDTH),
        diff_out.transpose(0, 2, 1, 3).reshape(bsz, seq, DIFF_V_WIDTH)], axis=-1)
    return merged @ w_o


def _hierarchical_moe(h, w_rg, b_rg, w_re, b_re, w_gate, w_up, w_down):
    bsz, seq, dm = h.shape
    n_tok = bsz * seq
    xt = h.reshape(n_tok, dm)
    g_logits = (xt @ w_rg).astype(jnp.float32) + b_rg.astype(jnp.float32)
    g_prob = jax.nn.softmax(g_logits, axis=-1)
    g_sel = jnp.argmax(g_logits, axis=-1)
    g_w = jnp.take_along_axis(g_prob, g_sel[:, None], axis=-1)
    e_logits = ((xt @ w_re).astype(jnp.float32) + b_re.astype(jnp.float32)).reshape(n_tok, N_GROUPS, EXPERTS_PER_GROUP)
    e_logits = jnp.take_along_axis(e_logits, g_sel[:, None, None], axis=1)[:, 0]
    e_prob = jax.nn.softmax(e_logits, axis=-1)
    top_w, top_i = lax.top_k(e_prob, TOP_K)
    top_w = top_w / jnp.sum(top_w, axis=-1, keepdims=True)
    gate = g_w * top_w
    expert_id = g_sel[:, None] * EXPERTS_PER_GROUP + top_i

    n_assign = n_tok * TOP_K
    chunk = DISPATCH_CHUNK
    n_slots = -(-n_assign // chunk) * chunk + N_EXPERTS * chunk
    n_chunks = n_slots // chunk
    eid = expert_id.reshape(n_assign).astype(jnp.int32)
    tok = jnp.repeat(jnp.arange(n_tok, dtype=jnp.int32), TOP_K)
    wts = gate.reshape(n_assign)
    order = jnp.argsort(eid)
    eid_s, tok_s, w_s = eid[order], tok[order], wts[order]
    counts = jnp.bincount(eid, length=N_EXPERTS)
    starts = jnp.cumsum(counts) - counts
    padded = (counts + chunk - 1) // chunk * chunk
    pends = jnp.cumsum(padded)
    pstarts = pends - padded
    dest = pstarts[eid_s] + (jnp.arange(n_assign, dtype=jnp.int32) - starts[eid_s])
    slot_tok = jnp.full((n_slots,), n_tok, dtype=jnp.int32).at[dest].set(tok_s)
    slot_w = jnp.zeros((n_slots,), jnp.float32).at[dest].set(w_s)
    chunk_start = jnp.arange(n_chunks, dtype=jnp.int32) * chunk
    chunk_expert = jnp.minimum(jnp.sum(chunk_start[:, None] >= pends[None, :], axis=1), N_EXPERTS - 1).astype(jnp.int32)
    x_pad = jnp.concatenate([xt, jnp.zeros((1, dm), xt.dtype)], axis=0)
    xs = x_pad[slot_tok].reshape(n_chunks, chunk, dm)

    def expert_chunk(args):
        xc, e = args
        hid = jax.nn.silu(xc @ w_gate[e]) * (xc @ w_up[e])
        return hid @ w_down[e]

    ys = lax.map(expert_chunk, (xs, chunk_expert)).reshape(n_slots, dm)
    ys = ys * slot_w[:, None].astype(ys.dtype)
    out = jnp.zeros((n_tok + 1, dm), ys.dtype).at[slot_tok].add(ys)[:n_tok]
    return out.reshape(bsz, seq, dm)


def setup_inputs(seed: int = 0) -> dict:
    key = jax.random.key(seed)
    ks = jax.random.split(key, 18)
    f32 = jnp.float32
    col_scale = jnp.concatenate([
        jnp.ones((2 * FOX_WIDTH,), f32), jnp.full((FOX_WIDTH,), DEEPNORM_BETA, f32),
        jnp.ones((FOX_HEADS + 2 * DIFF_QK_WIDTH,), f32), jnp.full((DIFF_V_WIDTH,), DEEPNORM_BETA, f32)])
    x = jax.random.normal(ks[0], (BATCH, SEQ, D_MODEL), f32)
    w_in = jax.random.normal(ks[1], (DEPTH, D_MODEL, IN_WIDTH), f32) * (D_MODEL ** -0.5) * col_scale
    b_f = jax.random.uniform(ks[2], (DEPTH, FOX_HEADS), f32, 1.0, 4.0)
    diff_lambda = jax.random.normal(ks[3], (DEPTH, 4, HEAD_DIM), f32) * 0.1
    diff_subln_g = 1.0 + 0.02 * jax.random.normal(ks[4], (DEPTH, 2 * HEAD_DIM), f32)
    w_o = jax.random.normal(ks[5], (DEPTH, MIX_WIDTH, D_MODEL), f32) * (MIX_WIDTH ** -0.5) * DEEPNORM_BETA
    ln1_g = 1.0 + 0.02 * jax.random.normal(ks[6], (DEPTH, D_MODEL), f32)
    ln1_b = 0.02 * jax.random.normal(ks[7], (DEPTH, D_MODEL), f32)
    w_router_group = jax.random.normal(ks[8], (DEPTH, D_MODEL, N_GROUPS), f32) * (D_MODEL ** -0.5)
    b_router_group = 0.01 * jax.random.normal(ks[9], (DEPTH, N_GROUPS), f32)
    w_router_expert = jax.random.normal(ks[10], (DEPTH, D_MODEL, N_EXPERTS), f32) * (D_MODEL ** -0.5)
    b_router_expert = 0.01 * jax.random.normal(ks[11], (DEPTH, N_EXPERTS), f32)
    w_gate = jax.random.normal(ks[12], (DEPTH, N_EXPERTS, D_MODEL, D_EXPERT), f32) * (D_MODEL ** -0.5)
    w_up = jax.random.normal(ks[13], (DEPTH, N_EXPERTS, D_MODEL, D_EXPERT), f32) * (D_MODEL ** -0.5)
    w_down = jax.random.normal(ks[14], (DEPTH, N_EXPERTS, D_EXPERT, D_MODEL), f32) * (D_EXPERT ** -0.5) * DEEPNORM_BETA
    ln2_g = 1.0 + 0.02 * jax.random.normal(ks[15], (DEPTH, D_MODEL), f32)
    ln2_b = 0.02 * jax.random.normal(ks[16], (DEPTH, D_MODEL), f32)
    return {"x": x, "w_in": w_in, "b_f": b_f, "diff_lambda": diff_lambda, "diff_subln_g": diff_subln_g,
            "w_o": w_o, "ln1_g": ln1_g, "ln1_b": ln1_b, "w_router_group": w_router_group,
            "b_router_group": b_router_group, "w_router_expert": w_router_expert,
            "b_router_expert": b_router_expert, "w_gate": w_gate, "w_up": w_up, "w_down": w_down,
            "ln2_g": ln2_g, "ln2_b": ln2_b}


def reference(x, w_in, b_f, diff_lambda, diff_subln_g, w_o, ln1_g, ln1_b, w_router_group,
              b_router_group, w_router_expert, b_router_expert, w_gate, w_up, w_down, ln2_g, ln2_b):
    cos, sin = _rope_tables(x.shape[1])
    for l in range(DEPTH):
        lambda_init = 0.8 - 0.6 * math.exp(-0.3 * l)
        mix = _hybrid_mixer(x, w_in[l], b_f[l], diff_lambda[l], diff_subln_g[l], w_o[l], cos, sin, lambda_init)
        x = _layer_norm(DEEPNORM_ALPHA * x + mix, ln1_g[l], ln1_b[l])
        ffn = _hierarchical_moe(x, w_router_group[l], b_router_group[l], w_router_expert[l],
                                b_router_expert[l], w_gate[l], w_up[l], w_down[l])
        x = _layer_norm(DEEPNORM_ALPHA * x + ffn, ln2_g[l], ln2_b[l])
    return x
```

```cpp
#include <hip/hip_runtime.h>
#include <hip/hip_bf16.h>
#include <cstdio>
#include <cstdint>

#ifndef MK_PER_PHASE
#define MK_PER_PHASE 1
#endif

constexpr int BATCH = 2, SEQ = 8192, DM = 2048, DEPTH = 4, HD = 128, M = BATCH * SEQ;
constexpr int FOXH = 8, DIFH = 4, NPROJ = 6144, INW = 6152;
constexpr int NE = 32, DE = 512, NSLOT = 40960;
constexpr float LN_EPS = 1e-5f, RMS_EPS = 1e-5f;
constexpr float ALPHA = 1.681792830507429f;
constexpr int NPHASE = 1 + 8 * DEPTH;

#define GAS __attribute__((address_space(1)))
#define LAS __attribute__((address_space(3)))
typedef unsigned short bf16_t;
typedef short bf16x8 __attribute__((ext_vector_type(8)));
typedef short s16x4 __attribute__((ext_vector_type(4)));
typedef float f32x4 __attribute__((ext_vector_type(4)));
typedef float f32x2 __attribute__((ext_vector_type(2)));
typedef float f32x16 __attribute__((ext_vector_type(16)));
typedef unsigned u32x4 __attribute__((ext_vector_type(4)));
typedef unsigned u32x2 __attribute__((ext_vector_type(2)));
typedef GAS unsigned gu32;
#define RLX_AGENT __ATOMIC_RELAXED, __HIP_MEMORY_SCOPE_AGENT

constexpr size_t MiB = 1u << 20;
constexpr size_t WS_CTL = 0, CTL_ZERO_BYTES = 65536;
constexpr size_t WS_COS = 1 * MiB, WS_SIN = 1 * MiB + 512 * 1024;
constexpr size_t WS_WF = 2 * MiB, WS_WR = 2 * MiB + 256 * 1024;
constexpr size_t WS_LOGF = 3 * MiB, WS_TOK = 3 * MiB + 512 * 1024;
constexpr size_t WS_LIST = 4 * MiB;
constexpr size_t WS_WIN = 8 * MiB, WS_WO = 104 * MiB, WS_WGU = 136 * MiB, WS_WD = 648 * MiB;
constexpr size_t WS_P = 904 * MiB, WS_Q = 1032 * MiB, WS_XB = 1160 * MiB, WS_PROJ = 1224 * MiB, WS_MRG = 1416 * MiB, WS_OD = 1480 * MiB;
constexpr size_t WS_HID = 1608 * MiB, WS_YS = 1648 * MiB, WS_END = 1808 * MiB;
constexpr int CW_TMO = 0, CW_CNT = 1024, CW_BAR = 4096;

constexpr int RING_BYTES = 131072;
constexpr int TAB_OFF = RING_BYTES;
constexpr int T_CHUNK_E = TAB_OFF, T_PSTART = TAB_OFF + 1024, T_HIST = TAB_OFF + 1280, T_BASE = TAB_OFF + 1536, T_MISC = TAB_OFF + 1792, T_UTAB = TAB_OFF + 1856, T_ROWTAB = TAB_OFF + 2048;
constexpr int MISC_OFF = 147456 - 128;
constexpr int LDS_BYTES = 147456;

__device__ __forceinline__ unsigned cvt_pk_bf16(float lo, float hi) { unsigned r; asm volatile("v_cvt_pk_bf16_f32 %0, %1, %2" : "=v"(r) : "v"(lo), "v"(hi)); return r; }
__device__ __forceinline__ unsigned f2bf(float f) { unsigned u = __builtin_bit_cast(unsigned, f); return (u + 0x7fffu + ((u >> 16) & 1u)) >> 16; }
__device__ __forceinline__ unsigned pk2(float lo, float hi) { return f2bf(lo) | (f2bf(hi) << 16); }
__device__ __forceinline__ float bf_lo(unsigned w) { return __builtin_bit_cast(float, w << 16); }
__device__ __forceinline__ float bf_hi(unsigned w) { return __builtin_bit_cast(float, w & 0xffff0000u); }
__device__ __forceinline__ float wave_sum(float v) {
#pragma unroll
    for (int o = 1; o < 64; o <<= 1) v += __shfl_xor(v, o);
    return v;
}
__device__ __forceinline__ unsigned char* opaque_ptr(unsigned char* p) { asm volatile("" : "+s"(p)); return p; }
__device__ __forceinline__ int opaque_tid() { int t = threadIdx.x; asm volatile("" : "+v"(t)); return t; }
#define LDS_WAIT() asm volatile("s_waitcnt lgkmcnt(0)" ::: "memory")
#define VM_WAIT() asm volatile("s_waitcnt vmcnt(0)" ::: "memory")

namespace pg8 {
constexpr int BM = 256, BK = 64, HALF = 128, HTB = HALF * BK * 2, STAGE_BYTES = 8 * HTB, NXCD = 8, WGM = 8;
__host__ __device__ __forceinline__ int lds_byte(int r, int c) { const int st = (r >> 4) * 2 + (c >> 5), rr = r & 15, cc = c & 31, ob = rr * 64 + cc * 2; return st * 1024 + (ob ^ (((ob >> 9) & 1) << 5)); }
__host__ __device__ __forceinline__ void stage_rc(int b, int& R, int& C) { const int st = b / 1024, sb = b % 1024, swz = sb ^ (((sb >> 9) & 1) << 5); R = (st >> 1) * 16 + swz / 64; C = (st & 1) * 32 + (swz % 64) / 2; }
__host__ __device__ __forceinline__ int perm32(int rho) { const int n = rho >> 4, i = rho & 15; return 8 * (i >> 2) + 4 * n + (i & 3); }

struct Unit { int pm, pn; };
struct Gemm { const bf16_t* A; const bf16_t* Bt; int K; };

struct StaticOrder {
    int nM, nN, nwg, G, c;
    __device__ void init(int Mr, int N, int G_, int c_) { nM = Mr / BM; nN = N / BM; nwg = nM * nN; G = G_; c = c_; }
    __device__ bool next(int i, Unit& u) const {
        const long L = (long)i * G + c; if (L >= nwg) return false;
        int wgid = (int)L; { const int q = nwg / NXCD, r = nwg % NXCD, xcd = wgid % NXCD, off = wgid / NXCD; wgid = (xcd < r ? xcd * (q + 1) : r * (q + 1) + (xcd - r) * q) + off; }
        const int nig = WGM * nN, gid = wgid / nig, fm = gid * WGM, gsz = (nM - fm) < WGM ? (nM - fm) : WGM;
        u.pm = fm + ((wgid % nig) % gsz); u.pn = (wgid % nig) / gsz; return true;
    }
};
struct TabOrder {
    int n; const LAS int* utab; const LAS unsigned* rowtab;
    __device__ __forceinline__ bool next(int i, Unit& u) const { if (i >= n) return false; u.pm = __builtin_amdgcn_readfirstlane(utab[2 * i]); u.pn = __builtin_amdgcn_readfirstlane(utab[2 * i + 1]); return true; }
    __device__ __forceinline__ const LAS unsigned* rows(int i) const { return rowtab + 256 * i; }
};
__device__ __forceinline__ bool grouped_unit(int U, int x, int j, int G8, int ntn_shift, const LAS int* chunk_e, int i, Unit& u) {
    const int q = U / 8, r = U % 8; const int lo = x * q + (x < r ? x : r), sz = q + (x < r ? 1 : 0);
    const int idx = j + i * G8; if (idx >= sz) return false;
    const int L = lo + idx, chunk = L >> ntn_shift, cn = L & ((1 << ntn_shift) - 1);
    u.pm = chunk; u.pn = (chunk_e[chunk] << ntn_shift) + cn; return true;
}

template <class Epi, class Sched, bool GATHER>
__device__ __forceinline__ void gemm_phase(LAS unsigned char* lds, const Gemm g, const Sched& S, const Epi& E) {
    const int tid = opaque_tid(), wid = __builtin_amdgcn_readfirstlane(tid >> 6), lane = tid & 63, wr = wid >> 2, wc = wid & 3, fr = lane & 15, fq = lane >> 4;
    const int K = g.K, nt = K / BK;
    unsigned voffA[2], voffB[2]; int RA[2];
#pragma unroll
    for (int i = 0; i < 2; ++i) { int R, C; stage_rc(tid * 16 + i * 8192, R, C); const int Rb = Epi::PERM ? ((R & ~31) + perm32(R & 31)) : R;
        voffA[i] = GATHER ? (unsigned)(C * 2) : (unsigned)(R * K + C) * 2u; voffB[i] = (unsigned)(Rb * K + C) * 2u; RA[i] = R; }
    const size_t kstep = (size_t)(BK * 2);
    const size_t hstep = (size_t)HALF * K * 2;
    const size_t tstep = 2 * hstep;
    const unsigned ldsw = (unsigned)wid * 1024u;
    const int aoff = lds_byte(wr * 64 + fr, fq * 8), boff = lds_byte(wc * 32 + fr, fq * 8);
#define PG8_SA(b, h) (((b) * 2 + (h)) * HTB)
#define PG8_SB(b, h) ((4 + (b) * 2 + (h)) * HTB)
#define PG8_STAGE2(bufoff, gbase, v0, v1) do { \
        __builtin_amdgcn_global_load_lds((const unsigned*)((const char*)(gbase) + (v0)), (LAS unsigned*)(lds + (bufoff) + ldsw), 16, 0, 0); \
        __builtin_amdgcn_global_load_lds((const unsigned*)((const char*)(gbase) + (v1)), (LAS unsigned*)(lds + (bufoff) + ldsw + 8192), 16, 0, 0); } while (0)
#define PG8_STAGEB(bufoff, gbase) PG8_STAGE2(bufoff, gbase, voffB[0], voffB[1])
#define PG8_STAGEA(bufoff, gbase, h, NX) do { if constexpr (GATHER) { PG8_STAGE2(bufoff, gbase, va[h][0], va[h][1]); } \
        else { PG8_STAGE2(bufoff, (gbase) + (h) * hstep, voffA[0], voffA[1]); } } while (0)
#define PG8_LDA(dst, b, h) do { _Pragma("unroll") for (int m = 0; m < 4; ++m) _Pragma("unroll") for (int k = 0; k < 2; ++k) dst[m][k] = *(const LAS bf16x8*)(lds + PG8_SA(b, h) + aoff + m * 2048 + k * 1024); } while (0)
#define PG8_LDB(dst, b, h) do { _Pragma("unroll") for (int n = 0; n < 2; ++n) _Pragma("unroll") for (int k = 0; k < 2; ++k) dst[n][k] = *(const LAS bf16x8*)(lds + PG8_SB(b, h) + boff + n * 2048 + k * 1024); } while (0)
#define PG8_MMA(ai, bj, At, Bt) do { __builtin_amdgcn_s_setprio(1); _Pragma("unroll") for (int m = 0; m < 4; ++m) _Pragma("unroll") for (int n = 0; n < 2; ++n) _Pragma("unroll") for (int k = 0; k < 2; ++k) \
        acc[ai][bj][m][n] = __builtin_amdgcn_mfma_f32_16x16x32_bf16(Bt[n][k], At[m][k], acc[ai][bj][m][n], 0, 0, 0); __builtin_amdgcn_s_setprio(0); } while (0)
#define PG8_WAIT_V(n) asm volatile("s_waitcnt vmcnt(" #n ")" ::: "memory")
#define PG8_WAIT_L(n) asm volatile("s_waitcnt lgkmcnt(" #n ")" ::: "memory")
#define PG8_BAR __builtin_amdgcn_s_barrier()
#define PG8_SCHED __builtin_amdgcn_sched_barrier(0)
    Unit cur, nxt; int ui = 0;
    if (!S.next(0, cur)) return;
    f32x4 acc[2][2][4][2];
#pragma unroll
    for (int a = 0; a < 2; ++a)
#pragma unroll
        for (int b = 0; b < 2; ++b)
#pragma unroll
            for (int m = 0; m < 4; ++m)
#pragma unroll
                for (int n = 0; n < 2; ++n) acc[a][b][m][n] = (f32x4){0.f, 0.f, 0.f, 0.f};
    bf16x8 At[4][2], B0[2][2], B1[2][2];
    unsigned va[2][2];
    if constexpr (GATHER) { const LAS unsigned* rt = S.rows(0);
#pragma unroll
        for (int h = 0; h < 2; ++h)
#pragma unroll
            for (int i = 0; i < 2; ++i) va[h][i] = rt[h * HALF + RA[i]] + voffA[i]; }
    else { va[0][0] = va[0][1] = va[1][0] = va[1][1] = 0u; }
    const char* cA = GATHER ? (const char*)g.A : (const char*)g.A + (size_t)cur.pm * tstep; const char* cB = (const char*)g.Bt + (size_t)cur.pn * tstep;
    PG8_STAGEB(PG8_SB(0, 0), cB); PG8_STAGEB(PG8_SB(0, 1), cB + hstep); PG8_STAGEA(PG8_SA(0, 0), cA, 0, false); PG8_STAGEA(PG8_SA(0, 1), cA, 1, false);
    if (wr == 1) PG8_BAR;
    PG8_WAIT_V(2); PG8_BAR;
    PG8_STAGEB(PG8_SB(1, 0), cB + kstep); PG8_STAGEA(PG8_SA(1, 0), cA + kstep, 0, false); PG8_STAGEB(PG8_SB(1, 1), cB + hstep + kstep);
    PG8_WAIT_V(6); PG8_BAR;
    for (;;) {
        const bool has_next = S.next(ui + 1, nxt);
        const char* nA = GATHER ? cA : (has_next ? (const char*)g.A + (size_t)nxt.pm * tstep : cA); const char* nB = has_next ? (const char*)g.Bt + (size_t)nxt.pn * tstep : cB;
#pragma nounroll
        for (int t = 0; t < nt; t += 2) {
            const bool last = (t == nt - 2);
            const char* a1 = cA + (size_t)(t + 1) * kstep;
            const char* a2 = last ? nA : cA + (size_t)(t + 2) * kstep; const char* b2 = last ? nB : cB + (size_t)(t + 2) * kstep;
            const char* a3 = a2 + kstep; const char* b3 = b2 + kstep;
            PG8_LDB(B0, 0, 0); PG8_LDB(B1, 0, 1); PG8_SCHED; PG8_LDA(At, 0, 0); PG8_STAGEA(PG8_SA(1, 1), a1, 1, false);
            if constexpr (GATHER) { if (last && has_next) { const LAS unsigned* rt = S.rows(ui + 1);
#pragma unroll
                for (int h = 0; h < 2; ++h)
#pragma unroll
                    for (int i = 0; i < 2; ++i) va[h][i] = rt[h * HALF + RA[i]] + voffA[i]; } }
            PG8_WAIT_V(8); PG8_WAIT_L(0); PG8_BAR; PG8_MMA(0, 0, At, B0); PG8_MMA(0, 1, At, B1); PG8_BAR; PG8_SCHED;
            PG8_LDA(At, 0, 1); PG8_STAGEB(PG8_SB(0, 0), b2); PG8_STAGEB(PG8_SB(0, 1), b2 + hstep); PG8_STAGEA(PG8_SA(0, 0), a2, 0, last);
            PG8_WAIT_V(8); PG8_WAIT_L(0); PG8_BAR; PG8_MMA(1, 0, At, B0); PG8_MMA(1, 1, At, B1); PG8_BAR; PG8_SCHED;
            PG8_LDB(B0, 1, 0); PG8_LDB(B1, 1, 1); PG8_SCHED; PG8_LDA(At, 1, 0); PG8_STAGEA(PG8_SA(0, 1), a2, 1, last);
            PG8_WAIT_V(8); PG8_WAIT_L(0); PG8_BAR; PG8_MMA(0, 0, At, B0); PG8_MMA(0, 1, At, B1); PG8_BAR; PG8_SCHED;
            PG8_LDA(At, 1, 1); PG8_STAGEB(PG8_SB(1, 0), b3); PG8_STAGEB(PG8_SB(1, 1), b3 + hstep); PG8_STAGEA(PG8_SA(1, 0), a3, 0, last);
            PG8_WAIT_V(8); PG8_WAIT_L(0); PG8_BAR; PG8_MMA(1, 0, At, B0); PG8_MMA(1, 1, At, B1); PG8_BAR; PG8_SCHED;
        }
        if (wr == 0) PG8_BAR;
        E(acc, cur, wr, wc, fr, fq);
        if (!has_next) break;
#pragma unroll
        for (int a = 0; a < 2; ++a)
#pragma unroll
            for (int b = 0; b < 2; ++b)
#pragma unroll
                for (int m = 0; m < 4; ++m)
#pragma unroll
                    for (int n = 0; n < 2; ++n) acc[a][b][m][n] = (f32x4){0.f, 0.f, 0.f, 0.f};
        cur = nxt; cA = nA; cB = nB; ++ui;
        if (wr == 1) PG8_BAR;
    }
    PG8_WAIT_V(0);
    PG8_BAR;
#undef PG8_SA
#undef PG8_SB
#undef PG8_STAGE2
#undef PG8_STAGEB
#undef PG8_STAGEA
#undef PG8_LDA
#undef PG8_LDB
#undef PG8_MMA
#undef PG8_WAIT_V
#undef PG8_WAIT_L
#undef PG8_BAR
#undef PG8_SCHED
}

struct EpiInProj {
    static constexpr bool PERM = true;
    unsigned char* wsb;
    __device__ __forceinline__ void operator()(const f32x4 (&acc)[2][2][4][2], const Unit& u, int wr, int wc, int fr, int fq) const {
        const float* cosT = (const float*)(wsb + WS_COS); const float* sinT = (const float*)(wsb + WS_SIN);
        const int tsel = u.pn >> 2; bf16_t* base = (bf16_t*)(wsb + WS_PROJ) + (size_t)tsel * ((size_t)M * 1024);
        const int row0 = u.pm * BM + wr * 64 + fr, col0 = (u.pn & 3) * BM + wc * 32 + 8 * fq;
        const bool rope = (tsel == 3 || tsel == 4) && (wc == 0);
        const float sgn = (fq < 2) ? -1.f : 1.f; const int i0 = 8 * (fq & 1);
#pragma unroll
        for (int ai = 0; ai < 2; ++ai)
#pragma unroll
            for (int m = 0; m < 4; ++m) { const int row = row0 + ai * HALF + m * 16; bf16_t* rowp = base + (size_t)row * 1024 + col0;
                f32x4 c0 = (f32x4){1.f, 1.f, 1.f, 1.f}, c1 = c0, s0 = (f32x4){0.f, 0.f, 0.f, 0.f}, s1 = s0;
                if (rope) { const int pos = row & (SEQ - 1); c0 = *(const f32x4*)(cosT + pos * 16 + i0); c1 = *(const f32x4*)(cosT + pos * 16 + i0 + 4); s0 = *(const f32x4*)(sinT + pos * 16 + i0); s1 = *(const f32x4*)(sinT + pos * 16 + i0 + 4); }
#pragma unroll
                for (int bj = 0; bj < 2; ++bj) { f32x4 v0 = acc[ai][bj][m][0], v1 = acc[ai][bj][m][1];
                    if (rope) { f32x4 p0, p1;
#pragma unroll
                        for (int j = 0; j < 4; ++j) { p0[j] = __shfl_xor(v0[j], 32); p1[j] = __shfl_xor(v1[j], 32); }
                        v0 = v0 * c0 + (p0 * s0) * sgn; v1 = v1 * c1 + (p1 * s1) * sgn; }
                    u32x4 w; w.x = cvt_pk_bf16(v0[0], v0[1]); w.y = cvt_pk_bf16(v0[2], v0[3]); w.z = cvt_pk_bf16(v1[0], v1[1]); w.w = cvt_pk_bf16(v1[2], v1[3]);
                    *(u32x4*)(rowp + bj * HALF) = w; } }
    }
};
struct EpiRes {
    static constexpr bool PERM = false;
    const float* P; float* Qo; float alpha;
    __device__ __forceinline__ void operator()(const f32x4 (&acc)[2][2][4][2], const Unit& u, int wr, int wc, int fr, int fq) const {
        const int row0 = u.pm * BM + wr * 64 + fr, col0 = u.pn * BM + wc * 32 + 4 * fq;
#pragma unroll
        for (int ai = 0; ai < 2; ++ai)
#pragma unroll
            for (int m = 0; m < 4; ++m) { const size_t off = (size_t)(row0 + ai * HALF + m * 16) * DM + col0;
#pragma unroll
                for (int bj = 0; bj < 2; ++bj)
#pragma unroll
                    for (int n = 0; n < 2; ++n) { const f32x4 x = *(const f32x4*)(P + off + bj * HALF + n * 16); *(f32x4*)(Qo + off + bj * HALF + n * 16) = x * alpha + acc[ai][bj][m][n]; } }
    }
};
struct EpiSwiGLU {
    static constexpr bool PERM = true;
    bf16_t* H;
    __device__ __forceinline__ void operator()(const f32x4 (&acc)[2][2][4][2], const Unit& u, int wr, int wc, int fr, int fq) const {
        const int row0 = u.pm * BM + wr * 64 + fr, col0 = (u.pn & 3) * HALF + wc * 32 + 8 * fq;
#pragma unroll
        for (int ai = 0; ai < 2; ++ai)
#pragma unroll
            for (int m = 0; m < 4; ++m) { bf16_t* rowp = H + (size_t)(row0 + ai * HALF + m * 16) * DE + col0; float h[8];
#pragma unroll
                for (int n = 0; n < 2; ++n)
#pragma unroll
                    for (int j = 0; j < 4; ++j) { const float gg = acc[ai][0][m][n][j], uu = acc[ai][1][m][n][j];
                        h[n * 4 + j] = gg * uu * __builtin_amdgcn_rcpf(1.f + __builtin_amdgcn_exp2f(-1.4426950408889634f * gg)); }
                u32x4 w; w.x = cvt_pk_bf16(h[0], h[1]); w.y = cvt_pk_bf16(h[2], h[3]); w.z = cvt_pk_bf16(h[4], h[5]); w.w = cvt_pk_bf16(h[6], h[7]);
                *(u32x4*)rowp = w; }
    }
};
struct EpiDown {
    static constexpr bool PERM = true;
    bf16_t* Y;
    __device__ __forceinline__ void operator()(const f32x4 (&acc)[2][2][4][2], const Unit& u, int wr, int wc, int fr, int fq) const {
        const int row0 = u.pm * BM + wr * 64 + fr, col0 = (u.pn & 7) * BM + wc * 32 + 8 * fq;
#pragma unroll
        for (int ai = 0; ai < 2; ++ai)
#pragma unroll
            for (int m = 0; m < 4; ++m) { bf16_t* rowp = Y + (size_t)(row0 + ai * HALF + m * 16) * DM + col0;
#pragma unroll
                for (int bj = 0; bj < 2; ++bj) { const f32x4 v0 = acc[ai][bj][m][0], v1 = acc[ai][bj][m][1];
                    u32x4 w; w.x = cvt_pk_bf16(v0[0], v0[1]); w.y = cvt_pk_bf16(v0[2], v0[3]); w.z = cvt_pk_bf16(v1[0], v1[1]); w.w = cvt_pk_bf16(v1[2], v1[3]);
                    *(u32x4*)(rowp + bj * HALF) = w; } }
    }
};
}

namespace att {
using bf16 = __hip_bfloat16;
constexpr int D = 128, KP = 1024, OP = 2048;
constexpr float SCALE = 0.08838834764831845f;
constexpr float THR = 8.f;
constexpr int NW = 8, QBLK = 32, KVBLK = 64, QB = NW * QBLK;
constexpr int SHM_V = KVBLK * D * 2, SHM_K = KVBLK * D * 2;
constexpr int LDS_ATT = 2 * SHM_V + 2 * SHM_K + NW * 64 * 4;
constexpr int LDS_C = LDS_ATT, LDS_WT = LDS_C + SEQ * 4;
template <class A, class Bt> struct same_t { static constexpr bool v = false; };
template <class A> struct same_t<A, A> { static constexpr bool v = true; };
#define KSWZ(row, colB) ((row) * 256 + ((colB) ^ (((row) & 7) << 4)))
#define SBAR() __builtin_amdgcn_sched_barrier(0)
__device__ __forceinline__ int v_st(int k, int c) { const int kk = (k & ~0xC) | ((k & 4) << 1) | ((k & 8) >> 1); return ((kk >> 3) * 4 + (c >> 5)) * 512 + ((kk & 7) * 32 + (c & 31)) * 2; }
__device__ __forceinline__ int v_rd_base(int lane) { return ((lane & 3) << 3) | (((lane >> 2) & 3) << 6) | (((lane >> 4) & 1) << 5) | (((lane >> 5) & 1) << 8); }
constexpr int v_rd_off(int d0, int ks, int half) { return d0 * 512 + ks * 4096 + half * 2048; }
__device__ __forceinline__ int crow(int r, int hi) { return (r & 3) + 8 * (r >> 2) + 4 * hi; }
__device__ __forceinline__ unsigned cvtpk(float lo, float hi) { unsigned r; asm volatile("v_cvt_pk_bf16_f32 %0, %1, %2" : "=v"(r) : "v"(lo), "v"(hi)); return r; }
__device__ __forceinline__ bf16x8 load8(const bf16* p) { return *reinterpret_cast<const bf16x8*>(p); }
__device__ __forceinline__ void mask_tile(f32x16& p0, f32x16& p1, int dq, unsigned W) {
    const float NEG = -__builtin_inff();
#pragma unroll
    for (int r = 0; r < 16; ++r) {
        const int c = (r & 3) + 8 * (r >> 2);
        if ((unsigned)(dq - c) >= W) p0[r] = NEG;
        if ((unsigned)(dq - c - 32) >= W) p1[r] = NEG;
    }
}
__device__ __forceinline__ void partialSM(f32x16& p0, f32x16& p1, float& m_reg, float& mn, float& alpha) {
    float pmax = p0[0]; for (int r = 1; r < 16; ++r) pmax = fmaxf(pmax, p0[r]); for (int r = 0; r < 16; ++r) pmax = fmaxf(pmax, p1[r]);
    { auto rr = __builtin_amdgcn_permlane32_swap(__float_as_uint(pmax), __float_as_uint(pmax), false, false);
      pmax = fmaxf(__uint_as_float(rr[0]), __uint_as_float(rr[1])); }
    constexpr float C2 = 1.4426950408889634f * SCALE;
    if (__builtin_expect(__all((pmax - m_reg) * SCALE <= THR), 1)) { mn = m_reg; alpha = 1.f; }
    else { mn = fmaxf(m_reg, pmax); alpha = __builtin_amdgcn_exp2f((m_reg - mn) * C2); m_reg = mn; }
    const float mnL = -mn * C2;
    for (int r = 0; r < 16; ++r) p0[r] = fmaf(p0[r], C2, mnL); for (int r = 0; r < 16; ++r) p1[r] = fmaf(p1[r], C2, mnL);
    for (int r = 0; r < 16; ++r) p0[r] = __builtin_amdgcn_exp2f(p0[r]);
}
__device__ __forceinline__ void finishSM(f32x16& p0, f32x16& p1, float alpha, float& l_reg, bf16x8& pa0, bf16x8& pa1, bf16x8& pa2, bf16x8& pa3) {
    for (int r = 0; r < 16; ++r) p1[r] = __builtin_amdgcn_exp2f(p1[r]);
    float ps = 0; for (int r = 0; r < 16; ++r) ps += p0[r]; for (int r = 0; r < 16; ++r) ps += p1[r];
    { auto rr = __builtin_amdgcn_permlane32_swap(__float_as_uint(ps), __float_as_uint(ps), false, false);
      ps = __uint_as_float(rr[0]) + __uint_as_float(rr[1]); }
    l_reg = l_reg * alpha + ps;
#define PK4(P, B_, OUT) do { unsigned a0 = cvtpk(P[B_+0], P[B_+1]), a1 = cvtpk(P[B_+2], P[B_+3]);                          \
        unsigned b0 = cvtpk(P[B_+4], P[B_+5]), b1 = cvtpk(P[B_+6], P[B_+7]);                                             \
        auto r0 = __builtin_amdgcn_permlane32_swap(a0, b0, false, false); auto r1 = __builtin_amdgcn_permlane32_swap(a1, b1, false, false); \
        u32x4 w = {r0[0], r1[0], r0[1], r1[1]}; OUT = *reinterpret_cast<bf16x8*>(&w); } while (0)
    PK4(p0, 0, pa0); PK4(p0, 8, pa1); PK4(p1, 0, pa2); PK4(p1, 8, pa3);
#undef PK4
}
template <int KB, bool FOX>
__device__ __forceinline__ void qkt(f32x16& p0, f32x16& p1, const char* K_lds, int r32, int hi, const bf16x8* qr, const float* cb, float cqs) {
    if constexpr (FOX) { const f32x4* cp = (const f32x4*)cb + hi;
#pragma unroll
        for (int g = 0; g < 4; ++g) { const f32x4 a = cp[2 * g], b = cp[8 + 2 * g];
#pragma unroll
            for (int j = 0; j < 4; ++j) { p0[4 * g + j] = cqs - a[j]; p1[4 * g + j] = cqs - b[j]; } } }
    else { p0 = f32x16{}; p1 = f32x16{}; }
    const char* kb[4];
#pragma unroll
    for (int dd = 0; dd < 4; ++dd) kb[dd] = K_lds + KB * SHM_K + KSWZ(r32, (dd * 16 + hi * 8) * 2);
#pragma unroll
    for (int d0 = 0; d0 < 8; ++d0) { const char* a = kb[d0 & 3] + (d0 >> 2) * 128;
        bf16x8 b0 = *reinterpret_cast<const bf16x8*>(a);
        bf16x8 b1 = *reinterpret_cast<const bf16x8*>(a + 32 * 256);
        p0 = __builtin_amdgcn_mfma_f32_32x32x16_bf16(b0, qr[d0], p0, 0, 0, 0);
        p1 = __builtin_amdgcn_mfma_f32_32x32x16_bf16(b1, qr[d0], p1, 0, 0, 0); }
}
template <int VB>
__device__ __forceinline__ void pv_tile(f32x16* o, int vb0, bf16x8 pa0, bf16x8 pa1, bf16x8 pa2, bf16x8 pa3) {
#define TRRD(dst, off) asm volatile("ds_read_b64_tr_b16 %0, %1 offset:%2" : "=&v"(dst) : "v"(vb0), "i"(off) : "memory")
#define PV_D0(d0) do { s16x4 l0, l1, l2, l3, h0, h1, h2, h3; constexpr int b_ = VB * SHM_V + v_rd_off(d0, 0, 0); \
        TRRD(l0, b_); TRRD(h0, b_ + 2048); TRRD(l1, b_ + 4096); TRRD(h1, b_ + 6144); TRRD(l2, b_ + 8192); TRRD(h2, b_ + 10240); TRRD(l3, b_ + 12288); TRRD(h3, b_ + 14336); \
        asm volatile("s_waitcnt lgkmcnt(0)" ::: "memory"); SBAR();   \
        o[d0] = __builtin_amdgcn_mfma_f32_32x32x16_bf16(pa0, (bf16x8){l0[0], l0[1], l0[2], l0[3], h0[0], h0[1], h0[2], h0[3]}, o[d0], 0, 0, 0);   \
        o[d0] = __builtin_amdgcn_mfma_f32_32x32x16_bf16(pa1, (bf16x8){l1[0], l1[1], l1[2], l1[3], h1[0], h1[1], h1[2], h1[3]}, o[d0], 0, 0, 0);   \
        o[d0] = __builtin_amdgcn_mfma_f32_32x32x16_bf16(pa2, (bf16x8){l2[0], l2[1], l2[2], l2[3], h2[0], h2[1], h2[2], h2[3]}, o[d0], 0, 0, 0);   \
        o[d0] = __builtin_amdgcn_mfma_f32_32x32x16_bf16(pa3, (bf16x8){l3[0], l3[1], l3[2], l3[3], h3[0], h3[1], h3[2], h3[3]}, o[d0], 0, 0, 0); } while (0)
    PV_D0(0); PV_D0(1); PV_D0(2); PV_D0(3);
#undef PV_D0
#undef TRRD
}
template <class TOut> struct BlockRef { const bf16* Q; const bf16* K; const bf16* V; TOut* O; int P0; };
struct Seam { bf16x8 qr[8]; bf16x8 st_v0, st_v1, st_k0, st_k1; };
#define ROWB(p, k0, rr) ((const bf16*)((const char*)(p) + ((size_t)((k0) + (rr)) * KP * 2) + loff))
#define VMW() asm volatile("s_waitcnt vmcnt(0)" ::: "memory")
#define VMWN(n) asm volatile("s_waitcnt vmcnt(%0)" :: "i"(n) : "memory")
#define SLOAD_H(Kp, Vp, k0) do { S.st_v0 = load8(ROWB(Vp, k0, 0)); S.st_v1 = load8(ROWB(Vp, k0, 32));              \
                         S.st_k0 = load8(ROWB(Kp, k0, 0)); S.st_k1 = load8(ROWB(Kp, k0, 32)); } while (0)
#define SWRITE_HK(bf) do { *(bf16x8*)(K_lds + (bf) * SHM_K + kws) = S.st_k0; *(bf16x8*)(K_lds + (bf) * SHM_K + kws + 32 * 256) = S.st_k1; } while (0)
#define SWRITE_HV(bf) do { *(bf16x8*)(V_lds + (bf) * SHM_V + vst0) = S.st_v0; *(bf16x8*)(V_lds + (bf) * SHM_V + vst1) = S.st_v1; } while (0)
#define SWRITE_H(bf) do { SWRITE_HV(bf); SWRITE_HK(bf); } while (0)
template <class TOut>
__device__ __forceinline__ void prime(const BlockRef<TOut>& cur, char* lds, Seam& S) {
    const int tid = opaque_tid(), wid = __builtin_amdgcn_readfirstlane(tid >> 6), lane = tid & 63, r32 = lane & 31, hi = lane >> 5;
    const int sr = tid >> 4, sc = (tid & 15) * 8, kws = KSWZ(sr, sc * 2); char* K_lds = lds + 2 * SHM_V;
    const unsigned loff = (unsigned)(sr * KP + sc) * 2u, qoff = (unsigned)(r32 * KP + hi * 8) * 2u;
    { const char* qb_ = (const char*)cur.Q + (size_t)(wid * QBLK) * KP * 2;
#pragma unroll
    for (int d0 = 0; d0 < 8; ++d0) S.qr[d0] = load8((const bf16*)(qb_ + d0 * 32 + qoff)); }
    SLOAD_H(cur.K, cur.V, 0); VMW(); SWRITE_HK(0);
    __syncthreads();
}
template <class TOut, bool FOX>
__device__ __forceinline__ void block(const BlockRef<TOut>& cur, const BlockRef<TOut>& nxt, char* lds, Seam& S) {
    const int tid = opaque_tid(), wid = __builtin_amdgcn_readfirstlane(tid >> 6), lane = tid & 63, r32 = lane & 31, hi = lane >> 5;
    constexpr int W = SEQ;
    const int NT = (cur.P0 + QB - 1) / KVBLK + 1;
    const int qlo = cur.P0 + wid * QBLK, qm = qlo + r32 - 4 * hi;
    char* V_lds = lds; char* K_lds = lds + 2 * SHM_V;
    float* ws = (float*)(lds + 2 * SHM_V + 2 * SHM_K) + wid * 64; float* li_l = ws, * al_l = ws + 32;
    const float* c_l = (const float*)(lds + LDS_C);
    float cqs = 0.f; if constexpr (FOX) cqs = c_l[qlo + r32];
    float m_reg = -1e30f, l_reg = 0; f32x16 o[4] = {};
    const int sr = tid >> 4, sc = (tid & 15) * 8, vst0 = v_st(sr, sc), vst1 = v_st(32 + sr, sc), kws = KSWZ(sr, sc * 2);
    const unsigned loff = (unsigned)(sr * KP + sc) * 2u, qoff = (unsigned)(r32 * KP + hi * 8) * 2u;
    const int vb0 = (int)(uintptr_t)V_lds + v_rd_base(lane);
    const bf16* Kh = cur.K; const bf16* Vh = cur.V;
#define RESC(a) do { if (__any((a) < 1.f)) { if (hi == 0) al_l[r32] = (a); asm volatile("s_waitcnt lgkmcnt(0)" ::: "memory");              \
                     for (int d_ = 0; d_ < 4; ++d_) for (int r = 0; r < 16; ++r) o[d_][r] *= al_l[crow(r, hi)]; } } while (0)
#define KBASE(t) ((t) * KVBLK)
#define MASKT(P0_, P1_, t) do { const int kb_ = KBASE(t); if (kb_ + KVBLK - 1 > qlo) mask_tile(P0_, P1_, qm - kb_, (unsigned)W); } while (0)
    constexpr int NQL = 8;
#define SEAM_K0() do { VMWN(NQL); SWRITE_HK(0); SBAR(); } while (0)
    f32x16 pA0, pA1, pB0, pB1; float mnA, mnB, alA, alB; bf16x8 pa0, pa1, pa2, pa3;
    SWRITE_HV(0); SBAR();
    if (NT > 1) { SLOAD_H(Kh, Vh, KBASE(1)); }
    SBAR(); qkt<0, FOX>(pA0, pA1, K_lds, r32, hi, S.qr, c_l + KBASE(0), cqs);
    MASKT(pA0, pA1, 0); partialSM(pA0, pA1, m_reg, mnA, alA);
    if (NT > 1) { VMW(); SWRITE_H(1); }
    __syncthreads();
#define HALF_STEP(PX0, PX1, mnX, alX, PY0, PY1, alY, t, KB, VB, SB) do {                                                      \
        SBAR(); qkt<KB, FOX>(PX0, PX1, K_lds, r32, hi, S.qr, c_l + KBASE(t), cqs);                                          \
        finishSM(PY0, PY1, alY, l_reg, pa0, pa1, pa2, pa3); SBAR();                                                           \
        if ((t) + 1 < NT) { SLOAD_H(Kh, Vh, KBASE((t) + 1)); SBAR(); }                                                        \
        pv_tile<VB>(o, vb0, pa0, pa1, pa2, pa3); MASKT(PX0, PX1, (t)); partialSM(PX0, PX1, m_reg, mnX, alX);                \
        __syncthreads();                                                                                                      \
        if ((t) + 1 < NT) { VMW(); SWRITE_H(SB); }                                                                            \
        RESC(alX); __syncthreads(); } while (0)
    for (int t = 1; t + 1 < NT; t += 2) {
        HALF_STEP(pB0, pB1, mnB, alB, pA0, pA1, alA, t, 1, 0, 0);
        HALF_STEP(pA0, pA1, mnA, alA, pB0, pB1, alB, t + 1, 0, 1, 1);
    }
    const bool even = (NT & 1) == 0;
    if (even) { SBAR(); qkt<1, FOX>(pB0, pB1, K_lds, r32, hi, S.qr, c_l + KBASE(NT - 1), cqs); SBAR(); }
    SLOAD_H(nxt.K, nxt.V, 0); SBAR();
    { const char* qb_ = (const char*)nxt.Q + (size_t)(wid * QBLK) * KP * 2;
#pragma unroll
    for (int d0 = 0; d0 < 8; ++d0) S.qr[d0] = load8((const bf16*)(qb_ + d0 * 32 + qoff)); }
    SBAR();
    finishSM(pA0, pA1, alA, l_reg, pa0, pa1, pa2, pa3); SBAR();
    pv_tile<0>(o, vb0, pa0, pa1, pa2, pa3);
    if (even) { MASKT(pB0, pB1, NT - 1); partialSM(pB0, pB1, m_reg, mnB, alB); __syncthreads(); RESC(alB);
        finishSM(pB0, pB1, alB, l_reg, pa0, pa1, pa2, pa3); SBAR(); pv_tile<1>(o, vb0, pa0, pa1, pa2, pa3); }
    SBAR(); SEAM_K0();
    if (hi == 0) li_l[r32] = l_reg; asm volatile("s_waitcnt lgkmcnt(0)" ::: "memory");
    float rli[16];
#pragma unroll
    for (int r = 0; r < 16; ++r) rli[r] = __builtin_amdgcn_rcpf(li_l[crow(r, hi)]);
    char* Ow = (char*)(cur.O + (size_t)(wid * QBLK) * OP);
    const unsigned ooff = (unsigned)(4 * hi * OP + r32) * (unsigned)sizeof(TOut);
#pragma unroll
    for (int r = 0; r < 16; ++r) { char* Or = Ow + (size_t)((r & 3) + 8 * (r >> 2)) * OP * sizeof(TOut);
#pragma unroll
        for (int d0 = 0; d0 < 4; ++d0) { const float v = o[d0][r] * rli[r];
            if constexpr (same_t<TOut, float>::v) { *(float*)(Or + d0 * 32 * 4 + ooff) = v; }
            else { const float vn = __shfl_xor(v, 1);
                   if ((r32 & 1) == 0) *(unsigned*)(Or + d0 * 32 * 2 + ooff) = cvtpk(v, vn); } } }
    __syncthreads();
#undef RESC
#undef KBASE
#undef MASKT
#undef SEAM_K0
#undef HALF_STEP
}
#undef ROWB
#undef VMW
#undef VMWN
#undef SLOAD_H
#undef SWRITE_HK
#undef SWRITE_HV
#undef SWRITE_H
#undef KSWZ
#undef SBAR
__device__ __forceinline__ void fox_load_c(const float* logf_bh, char* lds, int tid) {
    const int lane = tid & 63, wid = tid >> 6;
    float* c_l = (float*)(lds + LDS_C); float* wt = (float*)(lds + LDS_WT);
    f32x4 v[4]; const f32x4* src = (const f32x4*)(logf_bh + 16 * tid);
#pragma unroll
    for (int i = 0; i < 4; ++i) v[i] = src[i];
    float run = 0.f;
#pragma unroll
    for (int i = 0; i < 4; ++i)
#pragma unroll
        for (int j = 0; j < 4; ++j) { run += v[i][j]; v[i][j] = run; }
    float inc = run;
#pragma unroll
    for (int o = 1; o < 64; o <<= 1) { const float t = __shfl_up(inc, o); if (lane >= o) inc += t; }
    if (lane == 63) wt[wid] = inc;
    __syncthreads();
    float base = inc - run;
    for (int w = 0; w < wid; ++w) base += wt[w];
    const float RS = 11.313708498984761f;
#pragma unroll
    for (int i = 0; i < 4; ++i) { f32x4 o;
#pragma unroll
        for (int j = 0; j < 4; ++j) o[j] = (v[i][j] + base) * RS;
        *(f32x4*)(c_l + 16 * tid + 4 * i) = o; }
}
}

#define XB_TMO      128
#define XB_XCNT(j)  (256  + 64 * (j))
#define XB_XSUB(j)  (1280 + 64 * (j))
#define XB_XGEN(j)  (2304 + 64 * (j))
#define XB_TOP      3328
#define XB_TOPGEN   3392
#define XCD_BAR_WORDS 3456
#define XB_SPIN_CAP (1u << 18)
__device__ __forceinline__ unsigned xb_ld(unsigned* p)              { return __hip_atomic_load(p, __ATOMIC_RELAXED, __HIP_MEMORY_SCOPE_AGENT); }
__device__ __forceinline__ unsigned xb_add(unsigned* p, unsigned v) { return __hip_atomic_fetch_add(p, v, __ATOMIC_RELAXED, __HIP_MEMORY_SCOPE_AGENT); }
__device__ __forceinline__ unsigned xb_xcc_id() { return (unsigned)__builtin_amdgcn_s_getreg((3 << 11) | 20) & 0xFu; }
#define XB_SPIN(cond, bar) do { unsigned _sp = 0; while (cond) { __builtin_amdgcn_s_sleep(1); \
    if ((++_sp & 255u) == 0u) { if (xb_ld(&(bar)[XB_TMO])) break; if (_sp > XB_SPIN_CAP) { atomicAdd(&(bar)[XB_TMO], 1u); break; } } } } while (0)
struct XcdBarrier { unsigned* bar; unsigned x; volatile LAS unsigned* st; };
__device__ __forceinline__ XcdBarrier xcd_barrier_post(unsigned* bar, volatile LAS unsigned* st) {
    XcdBarrier b; b.bar = bar; b.x = xb_xcc_id(); b.st = st;
    if (threadIdx.x == 0) (void)xb_add(&bar[XB_XCNT(b.x)], 1u);
    return b;
}
__device__ __forceinline__ void xcd_barrier_complete(unsigned* bar, unsigned x, unsigned& nloc, unsigned& nx) {
    const unsigned G = gridDim.x * gridDim.y * gridDim.z;
    unsigned sum, cnt, mine, sp = 0u;
    for (;;) {
        sum = 0u; cnt = 0u; mine = 0u;
#pragma unroll
        for (unsigned j = 0; j < 16; ++j) { const unsigned c = xb_ld(&bar[XB_XCNT(j)]); sum += c; cnt += (c > 0u) ? 1u : 0u; mine = (j == x) ? c : mine; }
        if (sum == G) break;
        __builtin_amdgcn_s_sleep(1);
        if ((++sp & 255u) == 0u) { if (xb_ld(&bar[XB_TMO])) break; if (sp > XB_SPIN_CAP) { atomicAdd(&bar[XB_TMO], 1u); break; } }
    }
    nloc = mine > 0u ? mine : 1u; nx = cnt > 0u ? cnt : 1u;
}
__device__ __forceinline__ void xcd_barrier(const XcdBarrier& b) {
    asm volatile("s_waitcnt vmcnt(0)" ::: "memory");
    __syncthreads();
    if (threadIdx.x == 0) {
        unsigned* bar = b.bar;
        __builtin_amdgcn_s_waitcnt(0);
        unsigned nloc = b.st[0], nx = b.st[1];
        if (nloc == 0u) { xcd_barrier_complete(bar, b.x, nloc, nx); b.st[0] = nloc; b.st[1] = nx; }
        const unsigned old = xb_add(&bar[XB_XSUB(b.x)], 1u);
        const unsigned gen = old / nloc;
        if (old + 1u == (gen + 1u) * nloc) {
            __builtin_amdgcn_fence(__ATOMIC_RELEASE, "agent");
            asm volatile("s_waitcnt vmcnt(0)" ::: "memory");
            const unsigned og = xb_add(&bar[XB_TOP], 1u);
            const unsigned tg = og / nx;
            if (og + 1u == (tg + 1u) * nx) xb_add(&bar[XB_TOPGEN], 1u);
            else XB_SPIN(xb_ld(&bar[XB_TOPGEN]) == tg, bar);
            __builtin_amdgcn_fence(__ATOMIC_ACQUIRE, "agent");
            xb_add(&bar[XB_XGEN(b.x)], 1u);
            asm volatile("s_waitcnt vmcnt(0)" ::: "memory");
        } else {
            XB_SPIN(xb_ld(&bar[XB_XGEN(b.x)]) == gen, bar);
            __builtin_amdgcn_fence(__ATOMIC_ACQUIRE, "agent");
            asm volatile("s_waitcnt vmcnt(0)" ::: "memory");
        }
    }
    __syncthreads();
}

struct Args { const float* in[17]; float* out; unsigned char* ws; int ph_lo, ph_hi; };
enum { I_X = 0, I_WIN, I_BF, I_DLAM, I_SUBG, I_WO, I_LN1G, I_LN1B, I_WRG, I_BRG, I_WRE, I_BRE, I_WG, I_WU, I_WDN, I_LN2G, I_LN2B };

__device__ __forceinline__ void transpose_item(const float* src, int ldw, bf16_t* dst, int ldd, LAS float* scr, int lane) {
#pragma unroll 8
    for (int i = 0; i < 32; ++i) { const int kk = 2 * i + (lane >> 5); scr[kk * 33 + (lane & 31)] = src[(size_t)kk * ldw + (lane & 31)]; }
    LDS_WAIT(); asm volatile("" ::: "memory");
    const int c = lane & 7;
#pragma unroll
    for (int j = 0; j < 4; ++j) { const int n = (lane >> 3) + 8 * j; const LAS float* s = scr + (8 * c) * 33 + n;
        u32x4 o; o.x = pk2(s[0 * 33], s[1 * 33]); o.y = pk2(s[2 * 33], s[3 * 33]); o.z = pk2(s[4 * 33], s[5 * 33]); o.w = pk2(s[6 * 33], s[7 * 33]);
        *(GAS u32x4*)(dst + (size_t)n * ldd + 8 * c) = o; }
    LDS_WAIT(); asm volatile("" ::: "memory");
}

template <int NT>
__device__ __forceinline__ void skinny_logits(const bf16_t* X, const bf16_t* Wt, LAS float* part, LAS float* logits, int tid) {
    const int lane = tid & 63, wid = __builtin_amdgcn_readfirstlane(tid >> 6), r = lane & 15, kq = lane >> 4;
    f32x4 acc[4][NT];
#pragma unroll
    for (int mt = 0; mt < 4; ++mt)
#pragma unroll
        for (int nt = 0; nt < NT; ++nt) acc[mt][nt] = (f32x4){0.f, 0.f, 0.f, 0.f};
    const bf16_t* ap = X + (size_t)r * DM + wid * 256 + kq * 8;
    const bf16_t* bp = Wt + (size_t)r * DM + wid * 256 + kq * 8;
#pragma unroll 2
    for (int ks = 0; ks < 8; ++ks) {
        bf16x8 a[4], b[NT];
#pragma unroll
        for (int mt = 0; mt < 4; ++mt) a[mt] = *(const GAS bf16x8*)(ap + (size_t)mt * 16 * DM + ks * 32);
#pragma unroll
        for (int nt = 0; nt < NT; ++nt) b[nt] = *(const GAS bf16x8*)(bp + (size_t)nt * 16 * DM + ks * 32);
#pragma unroll
        for (int mt = 0; mt < 4; ++mt)
#pragma unroll
            for (int nt = 0; nt < NT; ++nt) acc[mt][nt] = __builtin_amdgcn_mfma_f32_16x16x32_bf16(a[mt], b[nt], acc[mt][nt], 0, 0, 0);
    }
    constexpr int LW = 16 * NT;
#pragma unroll
    for (int mt = 0; mt < 4; ++mt)
#pragma unroll
        for (int nt = 0; nt < NT; ++nt)
#pragma unroll
            for (int g = 0; g < 4; ++g) part[(wid * 64 + mt * 16 + 4 * kq + g) * LW + nt * 16 + r] = acc[mt][nt][g];
    __syncthreads();
    for (int o = tid; o < 64 * LW; o += 512) { float s = 0.f;
#pragma unroll
        for (int w = 0; w < 8; ++w) s += part[w * 64 * LW + o];
        logits[o] = s; }
    __syncthreads();
}

__device__ __forceinline__ att::BlockRef<att::bf16> fox_ref(int L, int pass, const bf16_t* FQ, const bf16_t* FK, const bf16_t* FV, bf16_t* MRG) {
    const int bh = L >> 4, x = L & 15, qb = pass ? 31 - x : x, b = bh >> 3, h = bh & 7;
    const size_t rowb = (size_t)b * SEQ; att::BlockRef<att::bf16> r;
    r.Q = (const att::bf16*)FQ + (rowb + (size_t)qb * 256) * att::KP + h * HD; r.K = (const att::bf16*)FK + rowb * att::KP + h * HD; r.V = (const att::bf16*)FV + rowb * att::KP + h * HD;
    r.O = (att::bf16*)MRG + (rowb + (size_t)qb * 256) * att::OP + h * HD; r.P0 = qb * 256; return r;
}
__device__ __forceinline__ att::BlockRef<float> dif_ref(int L, int pass, const bf16_t* DQ, const bf16_t* DK, const bf16_t* DV, float* OD) {
    const int vh = L >> 4, x = L & 15, qb = pass ? 31 - x : x, v = vh & 1, j = (vh >> 1) & 1, h = (vh >> 2) & 3, b = vh >> 4;
    const size_t rowb = (size_t)b * SEQ; att::BlockRef<float> r;
    r.Q = (const att::bf16*)DQ + (rowb + (size_t)qb * 256) * att::KP + (2 * h + j) * HD; r.K = (const att::bf16*)DK + rowb * att::KP + (2 * h + j) * HD;
    r.V = (const att::bf16*)DV + rowb * att::KP + h * 256 + v * HD;
    r.O = OD + (rowb + (size_t)qb * 256) * att::OP + h * 512 + j * 256 + v * HD; r.P0 = qb * 256; return r;
}

__global__ void __launch_bounds__(512, 2) trunk_fwd(Args args) {
    extern __shared__ __attribute__((aligned(16))) unsigned char lds_raw[];
    LAS unsigned char* lds = (LAS unsigned char*)lds_raw;
    const int G = gridDim.x, bx = blockIdx.x;
    const int vcu = (G % 8 == 0) ? (bx % 8) * (G / 8) + bx / 8 : bx;
    volatile LAS unsigned* MISC = (volatile LAS unsigned*)(lds + MISC_OFF);
    if (threadIdx.x < 32) MISC[threadIdx.x] = 0u;
    __syncthreads();
#define PHASE_LOCALS const int tid = opaque_tid(), lane = tid & 63, wave = __builtin_amdgcn_readfirstlane(tid >> 6); unsigned char* ws = opaque_ptr(args.ws); unsigned* ctl = (unsigned*)(ws + WS_CTL); (void)lane; (void)wave; (void)ctl;
    const int lo = args.ph_lo, hi = args.ph_hi;
    const bool use_bar = (hi - lo) > 1;
    XcdBarrier bar; bar.bar = (unsigned*)(args.ws + WS_CTL) + CW_BAR; bar.x = 0; bar.st = nullptr;
    if (use_bar) bar = xcd_barrier_post((unsigned*)(args.ws + WS_CTL) + CW_BAR, MISC + 8);
#ifndef PH_MASK
#define PH_MASK 0x1ff
#endif
#define PHK(k) ((k) == 0 ? 0 : (((k) - 1) % 8) + 1)
#define IN(k) (((PH_MASK >> PHK(k)) & 1) && lo <= (k) && (k) < hi)
#define BOTH(k) (IN(k) && IN((k) + 1))
#define GRID_BAR() do { xcd_barrier(bar); } while (0)

#define WIN_T ((bf16_t*)(ws + WS_WIN))
#define WO_T ((bf16_t*)(ws + WS_WO))
#define WGU_T ((bf16_t*)(ws + WS_WGU))
#define WD_T ((bf16_t*)(ws + WS_WD))
#define WF_T ((bf16_t*)(ws + WS_WF))
#define WR_T ((bf16_t*)(ws + WS_WR))
#define COS ((float*)(ws + WS_COS))
#define SIN ((float*)(ws + WS_SIN))
#define LOGF ((float*)(ws + WS_LOGF))
#define TOK ((unsigned*)(ws + WS_TOK))
#define LIST ((int*)(ws + WS_LIST))
#define PB ((float*)(ws + WS_P))
#define QBUF ((float*)(ws + WS_Q))
#define XB ((bf16_t*)(ws + WS_XB))
#define PROJ ((bf16_t*)(ws + WS_PROJ))
#define MRG ((bf16_t*)(ws + WS_MRG))
#define OD ((float*)(ws + WS_OD))
#define HID ((bf16_t*)(ws + WS_HID))
#define YS ((bf16_t*)(ws + WS_YS))
    constexpr size_t PSTR = (size_t)M * 1024;
#define FQ (PROJ)
#define FK (PROJ + PSTR)
#define FV (PROJ + 2 * PSTR)
#define DQ (PROJ + 3 * PSTR)
#define DK (PROJ + 4 * PSTR)
#define DV (PROJ + 5 * PSTR)
    LAS int* utab = (LAS int*)(lds + T_UTAB); LAS unsigned* rowtab = (LAS unsigned*)(lds + T_ROWTAB);
#define x_in (args.in[I_X])
#define FILL_STATIC(Mr, Nc) do { if (tid < 64) { pg8::StaticOrder SO; SO.init(Mr, Nc, G, bx); pg8::Unit u_; u_.pm = 0; u_.pn = 0; const bool ok_ = (tid < 8) && SO.next(tid, u_); \
        if (tid < 8) { utab[2 * tid] = u_.pm; utab[2 * tid + 1] = u_.pn; } const unsigned long long m_ = __ballot(ok_); if (tid == 0) ((LAS int*)(lds + T_MISC))[1] = __popcll(m_); } __syncthreads(); } while (0)
#define FILL_GROUPED(U_, sh_) do { if (tid < 64) { pg8::Unit u_; u_.pm = 0; u_.pn = 0; const bool ok_ = (tid < 8) && pg8::grouped_unit(U_, bx % 8, bx / 8, G / 8, sh_, chunk_e, tid, u_); \
        if (tid < 8) { utab[2 * tid] = u_.pm; utab[2 * tid + 1] = u_.pn; } const unsigned long long m_ = __ballot(ok_); if (tid == 0) tmisc[1] = __popcll(m_); } __syncthreads(); } while (0)
    if (IN(0)) {
        PHASE_LOCALS
        LAS float* scr = (LAS float*)(lds + wave * 16384);
        const int gw = vcu * 8 + wave, NGW = G * 8;
        constexpr int I_A = DEPTH * 32 * 192, I_B = DEPTH * 32 * 64, I_C = DEPTH * NE * 32 * 16, I_E = DEPTH * NE * 8 * 64;
        constexpr int NITEMS = I_A + I_B + 2 * I_C + I_E;
        for (int it = gw; it < NITEMS; it += NGW) {
            int r = it;
            if (r < I_A) { const int l = r / (32 * 192), rem = r % (32 * 192), kb = rem / 192, nb = rem % 192; const int n0 = 32 * nb, sc0 = n0 + (n0 >= 3072 ? 8 : 0);
                transpose_item(args.in[I_WIN] + (size_t)l * DM * INW + (size_t)(64 * kb) * INW + sc0, INW, WIN_T + (size_t)l * NPROJ * DM + (size_t)n0 * DM + 64 * kb, DM, scr, lane); continue; }
            r -= I_A;
            if (r < I_B) { const int l = r / (32 * 64), rem = r % (32 * 64), kb = rem / 64, nb = rem % 64;
                transpose_item(args.in[I_WO] + (size_t)l * DM * DM + (size_t)(64 * kb) * DM + 32 * nb, DM, WO_T + (size_t)l * DM * DM + (size_t)(32 * nb) * DM + 64 * kb, DM, scr, lane); continue; }
            r -= I_B;
            if (r < 2 * I_C) { const int up = r >= I_C ? 1 : 0; if (up) r -= I_C; const int le = r / 512, rem = r % 512, kb = rem / 16, nb = rem % 16;
                const float* src = (up ? args.in[I_WU] : args.in[I_WG]) + (size_t)le * DM * DE + (size_t)(64 * kb) * DE + 32 * nb;
                const int drow = 256 * (nb >> 2) + 32 * (nb & 3) + 128 * up;
                transpose_item(src, DE, WGU_T + (size_t)le * 1024 * DM + (size_t)drow * DM + 64 * kb, DM, scr, lane); continue; }
            r -= 2 * I_C;
            { const int le = r / 512, rem = r % 512, kb = rem / 64, nb = rem % 64;
                transpose_item(args.in[I_WDN] + (size_t)le * DE * DM + (size_t)(64 * kb) * DM + 32 * nb, DM, WD_T + (size_t)le * DM * DE + (size_t)(32 * nb) * DE + 64 * kb, DE, scr, lane); }
        }
        const int gt = vcu * 512 + tid, NGT = G * 512;
        for (int idx = gt; idx < DEPTH * 16 * DM; idx += NGT) { const int l = idx / (16 * DM), rem = idx % (16 * DM), n = rem / DM, k = rem % DM;
            const float v = (n < 8) ? args.in[I_WIN][(size_t)l * DM * INW + (size_t)k * INW + 3072 + n] : 0.f; WF_T[idx] = (bf16_t)f2bf(v); }
        for (int idx = gt; idx < DEPTH * 48 * DM; idx += NGT) { const int l = idx / (48 * DM), rem = idx % (48 * DM), n = rem / DM, k = rem % DM;
            float v = 0.f; if (n < 4) v = args.in[I_WRG][(size_t)l * DM * 4 + (size_t)k * 4 + n]; else if (n < 36) v = args.in[I_WRE][(size_t)l * DM * 32 + (size_t)k * 32 + (n - 4)];
            WR_T[idx] = (bf16_t)f2bf(v); }
        for (int idx = gt; idx < SEQ * 16; idx += NGT) { const int pos = idx >> 4, i = idx & 15;
            const double inv = pow(500000.0, -(double)i * (1.0 / 16.0));
            const double ang = (double)pos * inv; COS[idx] = (float)cos(ang); SIN[idx] = (float)sin(ang); }
        for (int idx = gt; idx < M * DM / 8; idx += NGT) { const f32x4 a = *(const GAS f32x4*)(x_in + (size_t)idx * 8), b = *(const GAS f32x4*)(x_in + (size_t)idx * 8 + 4);
            u32x4 w; w.x = pk2(a[0], a[1]); w.y = pk2(a[2], a[3]); w.z = pk2(b[0], b[1]); w.w = pk2(b[2], b[3]); *(GAS u32x4*)(XB + (size_t)idx * 8) = w; }
        if (BOTH(0)) GRID_BAR();
    }

    for (int l = 0; l < DEPTH; ++l) {
        const int pb = 1 + 8 * l;
        const float lam_init = 0.8f - 0.6f * expf(-0.3f * (float)l);
#define Pin ((l == 0) ? x_in : (const float*)PB)
#define Pout ((l == DEPTH - 1) ? args.out : PB)
#define cnt (ctl + CW_CNT + l * 32 * 16)

        if (IN(pb + 0)) {
            PHASE_LOCALS
            LAS float* part = (LAS float*)(lds + 16384); LAS float* logits = (LAS float*)(lds + 114688);
            for (int tile = bx; tile < M / 64; tile += G) {
                skinny_logits<1>(XB + (size_t)tile * 64 * DM, WF_T + (size_t)l * 16 * DM, part, logits, tid);
                if (tid < 64) { const int token = tile * 64 + tid, b = token / SEQ, pos = token % SEQ;
#pragma unroll
                    for (int h = 0; h < 8; ++h) { const float z = logits[tid * 16 + h] + args.in[I_BF][l * 8 + h];
                        const float lf = fminf(z, 0.f) - log1pf(__expf(-fabsf(z)));
                        LOGF[(size_t)(b * 8 + h) * SEQ + pos] = lf; } }
                __syncthreads();
            }
            FILL_STATIC(M, NPROJ);
            pg8::Gemm g{XB, WIN_T + (size_t)l * NPROJ * DM, DM}; pg8::TabOrder S{((LAS int*)(lds + T_MISC))[1], utab, rowtab};
            pg8::EpiInProj E{ws};
            pg8::gemm_phase<pg8::EpiInProj, pg8::TabOrder, false>(lds, g, S, E);
            if (BOTH(pb + 0)) GRID_BAR();
        }

        if (IN(pb + 1)) {
            PHASE_LOCALS
            char* alds = (char*)lds_raw;
#ifndef NO_FOX
            {
                typedef att::BlockRef<att::bf16> BR;
                constexpr int TOTAL = BATCH * FOXH * 16;
                int L = vcu;
                if (L < TOTAL) {
                    int pass = 0; BR cur = fox_ref(L, 0, FQ, FK, FV, MRG); att::Seam S; att::prime<att::bf16>(cur, alds, S);
                    for (;;) {
                        if (pass == 0) { att::fox_load_c(LOGF + (size_t)(L >> 4) * SEQ, alds, tid); __syncthreads(); }
                        const bool more_pass = pass == 0, more_item = L + G < TOTAL, last = !more_pass && !more_item;
                        const int passn = more_pass ? 1 : 0, Ln = more_pass ? L : (more_item ? L + G : L);
                        const BR nxt = last ? cur : fox_ref(Ln, passn, FQ, FK, FV, MRG);
                        att::block<att::bf16, true>(cur, nxt, alds, S);
                        if (last) break;
                        cur = nxt; pass = passn; L = Ln;
                    }
                }
            }
#endif
#ifndef NO_DIF
            {
                typedef att::BlockRef<float> BR;
                constexpr int TOTAL = BATCH * DIFH * 4 * 16;
                int L = vcu;
                if (L < TOTAL) {
                    int pass = 0; BR cur = dif_ref(L, 0, DQ, DK, DV, OD); att::Seam S; att::prime<float>(cur, alds, S);
                    for (;;) {
                        const bool more_pass = pass == 0, more_item = L + G < TOTAL, last = !more_pass && !more_item;
                        const int passn = more_pass ? 1 : 0, Ln = more_pass ? L : (more_item ? L + G : L);
                        const BR nxt = last ? cur : dif_ref(Ln, passn, DQ, DK, DV, OD);
                        att::block<float, false>(cur, nxt, alds, S);
                        if (last) break;
                        cur = nxt; pass = passn; L = Ln;
                    }
                }
            }
#endif
            if (BOTH(pb + 1)) GRID_BAR();
        }

        if (IN(pb + 2)) {
            PHASE_LOCALS
            const float* lv = args.in[I_DLAM] + l * 4 * HD;
            float d1 = lv[lane] * lv[HD + lane] + lv[64 + lane] * lv[HD + 64 + lane], d2 = lv[2 * HD + lane] * lv[3 * HD + lane] + lv[2 * HD + 64 + lane] * lv[3 * HD + 64 + lane];
            d1 = wave_sum(d1); d2 = wave_sum(d2);
            const float lam = __expf(d1) - __expf(d2) + lam_init;
            const f32x4 gsub = *(const f32x4*)(args.in[I_SUBG] + l * 256 + 4 * lane);
            const float osc = 1.f - lam_init;
            const int gw = vcu * 8 + wave, NGW = G * 8;
            for (int task = gw; task < M * DIFH; task += NGW) { const int row = task >> 2, h = task & 3;
                const float* src = OD + (size_t)row * 2048 + h * 512 + 4 * lane;
                const f32x4 o1 = *(const GAS f32x4*)src, o2 = *(const GAS f32x4*)(src + 256);
                const f32x4 d = o1 - o2 * lam;
                const float ss = wave_sum((d[0] * d[0] + d[1] * d[1]) + (d[2] * d[2] + d[3] * d[3]));
                const float rs = (1.0f / sqrtf(ss * (1.f / 256.f) + RMS_EPS)) * osc;
                const f32x4 y = d * gsub * rs;
                u32x2 w; w.x = cvt_pk_bf16(y[0], y[1]); w.y = cvt_pk_bf16(y[2], y[3]);
                *(GAS u32x2*)(MRG + (size_t)row * DM + 1024 + h * 256 + 4 * lane) = w; }
            if (BOTH(pb + 2)) GRID_BAR();
        }

        if (IN(pb + 3)) {
            PHASE_LOCALS
            FILL_STATIC(M, DM);
            pg8::Gemm g{MRG, WO_T + (size_t)l * DM * DM, DM}; pg8::TabOrder S{((LAS int*)(lds + T_MISC))[1], utab, rowtab};
            pg8::EpiRes E{Pin, QBUF, ALPHA};
            pg8::gemm_phase<pg8::EpiRes, pg8::TabOrder, false>(lds, g, S, E);
            if (BOTH(pb + 3)) GRID_BAR();
        }

        if (IN(pb + 4)) {
            PHASE_LOCALS
            LAS float* gl = (LAS float*)lds; LAS float* bl = (LAS float*)(lds + 8192);
            LAS float* part = (LAS float*)(lds + 16384); LAS float* logits = (LAS float*)(lds + 114688);
            LAS int* hist = (LAS int*)(lds + T_HIST); LAS int* basee = (LAS int*)(lds + T_BASE);
            for (int i = tid; i < DM; i += 512) { gl[i] = args.in[I_LN1G][l * DM + i]; bl[i] = args.in[I_LN1B][l * DM + i]; }
            __syncthreads();
            for (int tile = bx; tile < M / 64; tile += G) {
                for (int rr = 0; rr < 8; ++rr) { const int row = tile * 64 + wave * 8 + rr;
                    GAS f32x4* xr = (GAS f32x4*)(QBUF + (size_t)row * DM) + lane;
                    f32x4 v[8]; float s = 0.f;
#pragma unroll
                    for (int j = 0; j < 8; ++j) { v[j] = xr[64 * j]; s += (v[j][0] + v[j][1]) + (v[j][2] + v[j][3]); }
                    const float mean = wave_sum(s) * (1.f / DM); float s2 = 0.f;
#pragma unroll
                    for (int j = 0; j < 8; ++j) { v[j] = v[j] - mean; s2 += (v[j][0] * v[j][0] + v[j][1] * v[j][1]) + (v[j][2] * v[j][2] + v[j][3] * v[j][3]); }
                    const float rstd = 1.f / sqrtf(wave_sum(s2) * (1.f / DM) + LN_EPS);
                    GAS u32x2* o8 = (GAS u32x2*)(XB + (size_t)row * DM) + lane;
#pragma unroll
                    for (int j = 0; j < 8; ++j) { const f32x4 gg = *(const LAS f32x4*)(gl + 256 * j + 4 * lane), bb = *(const LAS f32x4*)(bl + 256 * j + 4 * lane);
                        const f32x4 y = v[j] * rstd * gg + bb; xr[64 * j] = y;
                        u32x2 w; w.x = cvt_pk_bf16(y[0], y[1]); w.y = cvt_pk_bf16(y[2], y[3]); o8[64 * j] = w; }
                }
                if (tid < 32) hist[tid] = 0;
                VM_WAIT(); __syncthreads();
                skinny_logits<3>(XB + (size_t)tile * 64 * DM, WR_T + (size_t)l * 48 * DM, part, logits, tid);
                int e0 = 0, e1 = 0, lr0 = 0, lr1 = 0; float w0 = 0.f, w1 = 0.f;
                if (tid < 64) {
                    const LAS float* lg = logits + tid * 48;
                    float gv[4]; int gs = 0; float gm;
#pragma unroll
                    for (int q = 0; q < 4; ++q) gv[q] = lg[q] + args.in[I_BRG][l * 4 + q];
                    gm = gv[0];
#pragma unroll
                    for (int q = 1; q < 4; ++q) if (gv[q] > gm) { gm = gv[q]; gs = q; }
                    float gsum = 0.f;
#pragma unroll
                    for (int q = 0; q < 4; ++q) gsum += __expf(gv[q] - gm);
                    const float gw_ = 1.f / gsum;
                    float ev[8];
#pragma unroll
                    for (int q = 0; q < 8; ++q) ev[q] = lg[4 + gs * 8 + q] + args.in[I_BRE][l * 32 + gs * 8 + q];
                    int ia = 0; float va = ev[0];
#pragma unroll
                    for (int q = 1; q < 8; ++q) if (ev[q] > va) { va = ev[q]; ia = q; }
                    int ib = -1; float vb = -3.0e38f;
#pragma unroll
                    for (int q = 0; q < 8; ++q) if (q != ia && ev[q] > vb) { vb = ev[q]; ib = q; }
                    const float eb = __expf(vb - va), den = 1.f / (1.f + eb);
                    w0 = gw_ * den; w1 = gw_ * eb * den;
                    e0 = gs * 8 + ia; e1 = gs * 8 + ib;
                    lr0 = __hip_atomic_fetch_add(&hist[e0], 1, __ATOMIC_RELAXED, __HIP_MEMORY_SCOPE_WORKGROUP); lr1 = __hip_atomic_fetch_add(&hist[e1], 1, __ATOMIC_RELAXED, __HIP_MEMORY_SCOPE_WORKGROUP);
                }
                __syncthreads();
                if (tid < 32) { const int n = hist[tid]; int b0 = 0; if (n > 0) b0 = (int)__hip_atomic_fetch_add(cnt + tid * 16, (unsigned)n, RLX_AGENT); basee[tid] = b0; }
                __syncthreads();
                if (tid < 64) { const int token = tile * 64 + tid; const int r0 = basee[e0] + lr0, r1 = basee[e1] + lr1;
                    LIST[e0 * M + r0] = token; LIST[e1 * M + r1] = token;
                    u32x4 ta; ta.x = (unsigned)e0; ta.y = (unsigned)r0; ta.z = (unsigned)e1; ta.w = (unsigned)r1;
                    u32x4 tb; tb.x = __float_as_uint(w0); tb.y = __float_as_uint(w1); tb.z = 0u; tb.w = 0u;
                    *(GAS u32x4*)(TOK + (size_t)token * 8) = ta; *(GAS u32x4*)(TOK + (size_t)token * 8 + 4) = tb; }
                __syncthreads();
            }
            if (BOTH(pb + 4)) GRID_BAR();
        }

        if (IN(pb + 5) || IN(pb + 6)) {
            PHASE_LOCALS
            LAS int* chunk_e = (LAS int*)(lds + T_CHUNK_E); LAS int* tmisc = (LAS int*)(lds + T_MISC);
            LAS int* pstart = (LAS int*)(lds + T_PSTART);
            if (tid == 0) { int C = 0;
_Pragma("nounroll")
                for (int e = 0; e < NE; ++e) { const int n = (int)__hip_atomic_load(cnt + e * 16, RLX_AGENT); const int nch = (n + 255) >> 8; pstart[e] = C;
_Pragma("nounroll")
                    for (int c = 0; c < nch; ++c) chunk_e[C + c] = e; C += nch; } tmisc[0] = C; }
            __syncthreads();
            const int C = tmisc[0];
            if (IN(pb + 5)) {
                FILL_GROUPED(C * 4, 2);
                const int nu = tmisc[1];
_Pragma("nounroll")
                for (int i = 0; i < nu; ++i) { const int pm_ = utab[2 * i], e = utab[2 * i + 1] >> 2, r0 = (pm_ - pstart[e]) * 256; const int n = (int)__hip_atomic_load(cnt + e * 16, RLX_AGENT);
                    for (int r = tid; r < 256; r += 512) { const int rk = (r0 + r < n) ? r0 + r : r0; rowtab[i * 256 + r] = (unsigned)LIST[e * M + rk] * (unsigned)(DM * 2); } }
                __syncthreads();
                pg8::TabOrder S{nu, utab, rowtab};
                pg8::Gemm g{XB, WGU_T + (size_t)l * NE * 1024 * DM, DM};
                pg8::EpiSwiGLU E{HID};
                pg8::gemm_phase<pg8::EpiSwiGLU, pg8::TabOrder, true>(lds, g, S, E);
                if (BOTH(pb + 5)) GRID_BAR();
            }
            if (IN(pb + 6)) {
                FILL_GROUPED(C * 8, 3);
                pg8::TabOrder S{tmisc[1], utab, rowtab};
                pg8::Gemm g{HID, WD_T + (size_t)l * NE * DM * DE, DE};
                pg8::EpiDown E{YS};
                pg8::gemm_phase<pg8::EpiDown, pg8::TabOrder, false>(lds, g, S, E);
                if (BOTH(pb + 6)) GRID_BAR();
            }
        }

        if (IN(pb + 7)) {
            PHASE_LOCALS
            LAS float* gl = (LAS float*)lds; LAS float* bl = (LAS float*)(lds + 8192); LAS int* pstart = (LAS int*)(lds + T_PSTART);
            for (int i = tid; i < DM; i += 512) { gl[i] = args.in[I_LN2G][l * DM + i]; bl[i] = args.in[I_LN2B][l * DM + i]; }
            if (tid == 0) { int C = 0;
_Pragma("nounroll")
                for (int e = 0; e < NE; ++e) { const int n = (int)__hip_atomic_load(cnt + e * 16, RLX_AGENT); pstart[e] = C * 256; C += (n + 255) >> 8; } }
            __syncthreads();
            const int gw = vcu * 8 + wave, NGW = G * 8;
            for (int row = gw; row < M; row += NGW) {
                const u32x4 ta = *(const GAS u32x4*)(TOK + (size_t)row * 8); const u32x2 tb = *(const GAS u32x2*)(TOK + (size_t)row * 8 + 4);
                const int s0 = pstart[ta.x] + (int)ta.y, s1 = pstart[ta.z] + (int)ta.w; const float w0 = __uint_as_float(tb.x), w1 = __uint_as_float(tb.y);
                const GAS f32x4* xr = (const GAS f32x4*)(QBUF + (size_t)row * DM) + lane;
                const GAS u32x2* y0 = (const GAS u32x2*)(YS + (size_t)s0 * DM) + lane; const GAS u32x2* y1 = (const GAS u32x2*)(YS + (size_t)s1 * DM) + lane;
                f32x4 v[8]; float s = 0.f;
#pragma unroll
                for (int j = 0; j < 8; ++j) { const f32x4 xx = xr[64 * j]; const u32x2 a = y0[64 * j], b = y1[64 * j];
                    f32x4 t; t[0] = xx[0] * ALPHA + (w0 * bf_lo(a.x) + w1 * bf_lo(b.x)); t[1] = xx[1] * ALPHA + (w0 * bf_hi(a.x) + w1 * bf_hi(b.x));
                    t[2] = xx[2] * ALPHA + (w0 * bf_lo(a.y) + w1 * bf_lo(b.y)); t[3] = xx[3] * ALPHA + (w0 * bf_hi(a.y) + w1 * bf_hi(b.y));
                    v[j] = t; s += (t[0] + t[1]) + (t[2] + t[3]); }
                const float mean = wave_sum(s) * (1.f / DM); float s2 = 0.f;
#pragma unroll
                for (int j = 0; j < 8; ++j) { v[j] = v[j] - mean; s2 += (v[j][0] * v[j][0] + v[j][1] * v[j][1]) + (v[j][2] * v[j][2] + v[j][3] * v[j][3]); }
                const float rstd = 1.f / sqrtf(wave_sum(s2) * (1.f / DM) + LN_EPS);
                GAS f32x4* po = (GAS f32x4*)(Pout + (size_t)row * DM) + lane; GAS u32x2* o8 = (GAS u32x2*)(XB + (size_t)row * DM) + lane;
#pragma unroll
                for (int j = 0; j < 8; ++j) { const f32x4 gg = *(const LAS f32x4*)(gl + 256 * j + 4 * lane), bb = *(const LAS f32x4*)(bl + 256 * j + 4 * lane);
                    const f32x4 y = v[j] * rstd * gg + bb; po[64 * j] = y;
                    u32x2 w; w.x = cvt_pk_bf16(y[0], y[1]); w.y = cvt_pk_bf16(y[2], y[3]); o8[64 * j] = w; }
            }
            if (BOTH(pb + 7)) GRID_BAR();
        }
    }
#undef IN
#undef BOTH
#undef GRID_BAR
}

extern "C" void kernel_launch(void* const* d_in, const int* in_sizes, int n_in, void* d_out, int out_size, void* d_ws, size_t ws_size, hipStream_t stream) {
    static int grid = 0;
    if (grid == 0) {
        if (n_in != 17 || in_sizes[0] != M * DM || out_size != M * DM || ws_size < WS_END) { fprintf(stderr, "kernel_launch: unexpected shapes (n_in %d in0 %d out %d ws %zu, need ws >= %zu); nothing launched\n", n_in, n_in > 0 ? in_sizes[0] : -1, out_size, ws_size, (size_t)WS_END); grid = -1; return; }
        int dev = 0, cus = 0, per_cu = 0;
        if (hipGetDevice(&dev) != hipSuccess || hipDeviceGetAttribute(&cus, hipDeviceAttributeMultiprocessorCount, dev) != hipSuccess) { grid = -1; return; }
        if (hipFuncSetAttribute((const void*)trunk_fwd, hipFuncAttributeMaxDynamicSharedMemorySize, LDS_BYTES) != hipSuccess) { fprintf(stderr, "kernel_launch: hipFuncSetAttribute failed\n"); grid = -1; return; }
        if (hipOccupancyMaxActiveBlocksPerMultiprocessor(&per_cu, (const void*)trunk_fwd, 512, LDS_BYTES) != hipSuccess || per_cu < 1) fprintf(stderr, "kernel_launch: occupancy query reports %d\n", per_cu);
        (void)hipGetLastError();
        grid = cus;
    }
    if (grid < 0) return;
    if (hipMemsetAsync((char*)d_ws + WS_CTL, 0, CTL_ZERO_BYTES, stream) != hipSuccess) return;
    Args a{};
    for (int i = 0; i < 17; ++i) a.in[i] = (const float*)d_in[i];
    a.out = (float*)d_out; a.ws = (unsigned char*)d_ws;
#if MK_PER_PHASE
    for (int ph = 0; ph < NPHASE; ++ph) { a.ph_lo = ph; a.ph_hi = ph + 1; hipLaunchKernelGGL(trunk_fwd, dim3(grid), dim3(512), LDS_BYTES, stream, a); }
#else
    a.ph_lo = 0; a.ph_hi = NPHASE; hipLaunchKernelGGL(trunk_fwd, dim3(grid), dim3(512), LDS_BYTES, stream, a);
#endif
}
```

```cpp
#include <hip/hip_runtime.h>
#include <hip/hip_bf16.h>
#include <cstdio>
#include <cstdint>

#ifndef MK_PER_PHASE
#define MK_PER_PHASE 0
#endif

constexpr int BATCH = 2, SEQ = 8192, DM = 2048, DEPTH = 4, HD = 128, M = BATCH * SEQ;
constexpr int FOXH = 8, DIFH = 4, NPROJ = 6144, INW = 6152;
constexpr int NE = 32, DE = 512, NSLOT = 40960;
constexpr float LN_EPS = 1e-5f, RMS_EPS = 1e-5f;
constexpr float ALPHA = 1.681792830507429f;
constexpr int NPHASE = 1 + 8 * DEPTH;

#define GAS __attribute__((address_space(1)))
#define LAS __attribute__((address_space(3)))
typedef unsigned short bf16_t;
typedef short bf16x8 __attribute__((ext_vector_type(8)));
typedef short s16x4 __attribute__((ext_vector_type(4)));
typedef float f32x4 __attribute__((ext_vector_type(4)));
typedef float f32x2 __attribute__((ext_vector_type(2)));
typedef float f32x16 __attribute__((ext_vector_type(16)));
typedef unsigned u32x4 __attribute__((ext_vector_type(4)));
typedef unsigned u32x2 __attribute__((ext_vector_type(2)));
typedef GAS unsigned gu32;
#define RLX_AGENT __ATOMIC_RELAXED, __HIP_MEMORY_SCOPE_AGENT

constexpr size_t MiB = 1u << 20;
constexpr size_t WS_CTL = 0, CTL_ZERO_BYTES = 65536;
constexpr size_t WS_COS = 1 * MiB, WS_SIN = 1 * MiB + 512 * 1024;
constexpr size_t WS_WF = 2 * MiB, WS_WR = 2 * MiB + 256 * 1024;
constexpr size_t WS_LOGF = 3 * MiB, WS_TOK = 3 * MiB + 512 * 1024;
constexpr size_t WS_LIST = 4 * MiB;
constexpr size_t WS_WIN = 8 * MiB, WS_WO = 104 * MiB, WS_WGU = 136 * MiB, WS_WD = 648 * MiB;
constexpr size_t WS_P = 904 * MiB, WS_Q = 1032 * MiB, WS_XB = 1160 * MiB, WS_PROJ = 1224 * MiB, WS_MRG = 1416 * MiB, WS_OD = 1480 * MiB;
constexpr size_t WS_HID = 1608 * MiB, WS_YS = 1648 * MiB, WS_END = 1808 * MiB;
constexpr int CW_TMO = 0, CW_CNT = 1024, CW_BAR = 4096;

constexpr int RING_BYTES = 131072;
constexpr int TAB_OFF = RING_BYTES;
constexpr int T_CHUNK_E = TAB_OFF, T_PSTART = TAB_OFF + 1024, T_HIST = TAB_OFF + 1280, T_BASE = TAB_OFF + 1536, T_MISC = TAB_OFF + 1792, T_UTAB = TAB_OFF + 1856, T_ROWTAB = TAB_OFF + 2048;
constexpr int MISC_OFF = 147456 - 128;
constexpr int LDS_BYTES = 147456;

__device__ __forceinline__ unsigned cvt_pk_bf16(float lo, float hi) { unsigned r; asm volatile("v_cvt_pk_bf16_f32 %0, %1, %2" : "=v"(r) : "v"(lo), "v"(hi)); return r; }
__device__ __forceinline__ unsigned f2bf(float f) { unsigned u = __builtin_bit_cast(unsigned, f); return (u + 0x7fffu + ((u >> 16) & 1u)) >> 16; }
__device__ __forceinline__ unsigned pk2(float lo, float hi) { return f2bf(lo) | (f2bf(hi) << 16); }
__device__ __forceinline__ float bf_lo(unsigned w) { return __builtin_bit_cast(float, w << 16); }
__device__ __forceinline__ float bf_hi(unsigned w) { return __builtin_bit_cast(float, w & 0xffff0000u); }
__device__ __forceinline__ float wave_sum(float v) {
#pragma unroll
    for (int o = 1; o < 64; o <<= 1) v += __shfl_xor(v, o);
    return v;
}
__device__ __forceinline__ unsigned char* opaque_ptr(unsigned char* p) { asm volatile("" : "+s"(p)); return p; }
__device__ __forceinline__ int opaque_tid() { int t = threadIdx.x; asm volatile("" : "+v"(t)); return t; }
#define LDS_WAIT() asm volatile("s_waitcnt lgkmcnt(0)" ::: "memory")
#define VM_WAIT() asm volatile("s_waitcnt vmcnt(0)" ::: "memory")

namespace pg8 {
constexpr int BM = 256, BK = 64, HALF = 128, HTB = HALF * BK * 2, STAGE_BYTES = 8 * HTB, NXCD = 8, WGM = 8;
__host__ __device__ __forceinline__ int lds_byte(int r, int c) { const int st = (r >> 4) * 2 + (c >> 5), rr = r & 15, cc = c & 31, ob = rr * 64 + cc * 2; return st * 1024 + (ob ^ (((ob >> 9) & 1) << 5)); }
__host__ __device__ __forceinline__ void stage_rc(int b, int& R, int& C) { const int st = b / 1024, sb = b % 1024, swz = sb ^ (((sb >> 9) & 1) << 5); R = (st >> 1) * 16 + swz / 64; C = (st & 1) * 32 + (swz % 64) / 2; }
__host__ __device__ __forceinline__ int perm32(int rho) { const int n = rho >> 4, i = rho & 15; return 8 * (i >> 2) + 4 * n + (i & 3); }

struct Unit { int pm, pn; };
struct Gemm { const bf16_t* A; const bf16_t* Bt; int K; };

struct StaticOrder {
    int nM, nN, nwg, G, c;
    __device__ void init(int Mr, int N, int G_, int c_) { nM = Mr / BM; nN = N / BM; nwg = nM * nN; G = G_; c = c_; }
    __device__ bool next(int i, Unit& u) const {
        const long L = (long)i * G + c; if (L >= nwg) return false;
        int wgid = (int)L; { const int q = nwg / NXCD, r = nwg % NXCD, xcd = wgid % NXCD, off = wgid / NXCD; wgid = (xcd < r ? xcd * (q + 1) : r * (q + 1) + (xcd - r) * q) + off; }
        const int nig = WGM * nN, gid = wgid / nig, fm = gid * WGM, gsz = (nM - fm) < WGM ? (nM - fm) : WGM;
        u.pm = fm + ((wgid % nig) % gsz); u.pn = (wgid % nig) / gsz; return true;
    }
};
struct TabOrder {
    int n; const LAS int* utab; const LAS unsigned* rowtab;
    __device__ __forceinline__ bool next(int i, Unit& u) const { if (i >= n) return false; u.pm = __builtin_amdgcn_readfirstlane(utab[2 * i]); u.pn = __builtin_amdgcn_readfirstlane(utab[2 * i + 1]); return true; }
    __device__ __forceinline__ const LAS unsigned* rows(int i) const { return rowtab + 256 * i; }
};
__device__ __forceinline__ bool grouped_unit(int U, int x, int j, int G8, int ntn_shift, const LAS int* chunk_e, int i, Unit& u) {
    const int q = U / 8, r = U % 8; const int lo = x * q + (x < r ? x : r), sz = q + (x < r ? 1 : 0);
    const int idx = j + i * G8; if (idx >= sz) return false;
    const int L = lo + idx, chunk = L >> ntn_shift, cn = L & ((1 << ntn_shift) - 1);
    u.pm = chunk; u.pn = (chunk_e[chunk] << ntn_shift) + cn; return true;
}

template <class Epi, class Sched, bool GATHER>
__device__ __forceinline__ void gemm_phase(LAS unsigned char* lds, const Gemm g, const Sched& S, const Epi& E) {
    const int tid = opaque_tid(), wid = __builtin_amdgcn_readfirstlane(tid >> 6), lane = tid & 63, wr = wid >> 2, wc = wid & 3, fr = lane & 15, fq = lane >> 4;
    const int K = g.K, nt = K / BK;
    unsigned voffA[2], voffB[2]; int RA[2];
#pragma unroll
    for (int i = 0; i < 2; ++i) { int R, C; stage_rc(tid * 16 + i * 8192, R, C); const int Rb = Epi::PERM ? ((R & ~31) + perm32(R & 31)) : R;
        voffA[i] = GATHER ? (unsigned)(C * 2) : (unsigned)(R * K + C) * 2u; voffB[i] = (unsigned)(Rb * K + C) * 2u; RA[i] = R; }
    const size_t kstep = (size_t)(BK * 2);
    const size_t hstep = (size_t)HALF * K * 2;
    const size_t tstep = 2 * hstep;
    const unsigned ldsw = (unsigned)wid * 1024u;
    const int aoff = lds_byte(wr * 64 + fr, fq * 8), boff = lds_byte(wc * 32 + fr, fq * 8);
#define PG8_SA(b, h) (((b) * 2 + (h)) * HTB)
#define PG8_SB(b, h) ((4 + (b) * 2 + (h)) * HTB)
#define PG8_STAGE2(bufoff, gbase, v0, v1) do { \
        __builtin_amdgcn_global_load_lds((const unsigned*)((const char*)(gbase) + (v0)), (LAS unsigned*)(lds + (bufoff) + ldsw), 16, 0, 0); \
        __builtin_amdgcn_global_load_lds((const unsigned*)((const char*)(gbase) + (v1)), (LAS unsigned*)(lds + (bufoff) + ldsw + 8192), 16, 0, 0); } while (0)
#define PG8_STAGEB(bufoff, gbase) PG8_STAGE2(bufoff, gbase, voffB[0], voffB[1])
#define PG8_STAGEA(bufoff, gbase, h, NX) do { if constexpr (GATHER) { PG8_STAGE2(bufoff, gbase, va[h][0], va[h][1]); } \
        else { PG8_STAGE2(bufoff, (gbase) + (h) * hstep, voffA[0], voffA[1]); } } while (0)
#define PG8_LDA(dst, b, h) do { _Pragma("unroll") for (int m = 0; m < 4; ++m) _Pragma("unroll") for (int k = 0; k < 2; ++k) dst[m][k] = *(const LAS bf16x8*)(lds + PG8_SA(b, h) + aoff + m * 2048 + k * 1024); } while (0)
#define PG8_LDB(dst, b, h) do { _Pragma("unroll") for (int n = 0; n < 2; ++n) _Pragma("unroll") for (int k = 0; k < 2; ++k) dst[n][k] = *(const LAS bf16x8*)(lds + PG8_SB(b, h) + boff + n * 2048 + k * 1024); } while (0)
#define PG8_MMA(ai, bj, At, Bt) do { __builtin_amdgcn_s_setprio(1); _Pragma("unroll") for (int m = 0; m < 4; ++m) _Pragma("unroll") for (int n = 0; n < 2; ++n) _Pragma("unroll") for (int k = 0; k < 2; ++k) \
        acc[ai][bj][m][n] = __builtin_amdgcn_mfma_f32_16x16x32_bf16(Bt[n][k], At[m][k], acc[ai][bj][m][n], 0, 0, 0); __builtin_amdgcn_s_setprio(0); } while (0)
#define PG8_WAIT_V(n) asm volatile("s_waitcnt vmcnt(" #n ")" ::: "memory")
#define PG8_WAIT_L(n) asm volatile("s_waitcnt lgkmcnt(" #n ")" ::: "memory")
#define PG8_BAR __builtin_amdgcn_s_barrier()
#define PG8_SCHED __builtin_amdgcn_sched_barrier(0)
    Unit cur, nxt; int ui = 0;
    if (!S.next(0, cur)) return;
    f32x4 acc[2][2][4][2];
#pragma unroll
    for (int a = 0; a < 2; ++a)
#pragma unroll
        for (int b = 0; b < 2; ++b)
#pragma unroll
            for (int m = 0; m < 4; ++m)
#pragma unroll
                for (int n = 0; n < 2; ++n) acc[a][b][m][n] = (f32x4){0.f, 0.f, 0.f, 0.f};
    bf16x8 At[4][2], B0[2][2], B1[2][2];
    unsigned va[2][2];
    if constexpr (GATHER) { const LAS unsigned* rt = S.rows(0);
#pragma unroll
        for (int h = 0; h < 2; ++h)
#pragma unroll
            for (int i = 0; i < 2; ++i) va[h][i] = rt[h * HALF + RA[i]] + voffA[i]; }
    else { va[0][0] = va[0][1] = va[1][0] = va[1][1] = 0u; }
    const char* cA = GATHER ? (const char*)g.A : (const char*)g.A + (size_t)cur.pm * tstep; const char* cB = (const char*)g.Bt + (size_t)cur.pn * tstep;
    PG8_STAGEB(PG8_SB(0, 0), cB); PG8_STAGEB(PG8_SB(0, 1), cB + hstep); PG8_STAGEA(PG8_SA(0, 0), cA, 0, false); PG8_STAGEA(PG8_SA(0, 1), cA, 1, false);
    if (wr == 1) PG8_BAR;
    PG8_WAIT_V(2); PG8_BAR;
    PG8_STAGEB(PG8_SB(1, 0), cB + kstep); PG8_STAGEA(PG8_SA(1, 0), cA + kstep, 0, false); PG8_STAGEB(PG8_SB(1, 1), cB + hstep + kstep);
    PG8_WAIT_V(6); PG8_BAR;
    for (;;) {
        const bool has_next = S.next(ui + 1, nxt);
        const char* nA = GATHER ? cA : (has_next ? (const char*)g.A + (size_t)nxt.pm * tstep : cA); const char* nB = has_next ? (const char*)g.Bt + (size_t)nxt.pn * tstep : cB;
#pragma nounroll
        for (int t = 0; t < nt; t += 2) {
            const bool last = (t == nt - 2);
            const char* a1 = cA + (size_t)(t + 1) * kstep;
            const char* a2 = last ? nA : cA + (size_t)(t + 2) * kstep; const char* b2 = last ? nB : cB + (size_t)(t + 2) * kstep;
            const char* a3 = a2 + kstep; const char* b3 = b2 + kstep;
            PG8_LDB(B0, 0, 0); PG8_LDB(B1, 0, 1); PG8_SCHED; PG8_LDA(At, 0, 0); PG8_STAGEA(PG8_SA(1, 1), a1, 1, false);
            if constexpr (GATHER) { if (last && has_next) { const LAS unsigned* rt = S.rows(ui + 1);
#pragma unroll
                for (int h = 0; h < 2; ++h)
#pragma unroll
                    for (int i = 0; i < 2; ++i) va[h][i] = rt[h * HALF + RA[i]] + voffA[i]; } }
            PG8_WAIT_V(8); PG8_WAIT_L(0); PG8_BAR; PG8_MMA(0, 0, At, B0); PG8_MMA(0, 1, At, B1); PG8_BAR; PG8_SCHED;
            PG8_LDA(At, 0, 1); PG8_STAGEB(PG8_SB(0, 0), b2); PG8_STAGEB(PG8_SB(0, 1), b2 + hstep); PG8_STAGEA(PG8_SA(0, 0), a2, 0, last);
            PG8_WAIT_V(8); PG8_WAIT_L(0); PG8_BAR; PG8_MMA(1, 0, At, B0); PG8_MMA(1, 1, At, B1); PG8_BAR; PG8_SCHED;
            PG8_LDB(B0, 1, 0); PG8_LDB(B1, 1, 1); PG8_SCHED; PG8_LDA(At, 1, 0); PG8_STAGEA(PG8_SA(0, 1), a2, 1, last);
            PG8_WAIT_V(8); PG8_WAIT_L(0); PG8_BAR; PG8_MMA(0, 0, At, B0); PG8_MMA(0, 1, At, B1); PG8_BAR; PG8_SCHED;
            PG8_LDA(At, 1, 1); PG8_STAGEB(PG8_SB(1, 0), b3); PG8_STAGEB(PG8_SB(1, 1), b3 + hstep); PG8_STAGEA(PG8_SA(1, 0), a3, 0, last);
            PG8_WAIT_V(8); PG8_WAIT_L(0); PG8_BAR; PG8_MMA(1, 0, At, B0); PG8_MMA(1, 1, At, B1); PG8_BAR; PG8_SCHED;
        }
        if (wr == 0) PG8_BAR;
        E(acc, cur, wr, wc, fr, fq);
        if (!has_next) break;
#pragma unroll
        for (int a = 0; a < 2; ++a)
#pragma unroll
            for (int b = 0; b < 2; ++b)
#pragma unroll
                for (int m = 0; m < 4; ++m)
#pragma unroll
                    for (int n = 0; n < 2; ++n) acc[a][b][m][n] = (f32x4){0.f, 0.f, 0.f, 0.f};
        cur = nxt; cA = nA; cB = nB; ++ui;
        if (wr == 1) PG8_BAR;
    }
    PG8_WAIT_V(0);
    PG8_BAR;
#undef PG8_SA
#undef PG8_SB
#undef PG8_STAGE2
#undef PG8_STAGEB
#undef PG8_STAGEA
#undef PG8_LDA
#undef PG8_LDB
#undef PG8_MMA
#undef PG8_WAIT_V
#undef PG8_WAIT_L
#undef PG8_BAR
#undef PG8_SCHED
}

struct EpiInProj {
    static constexpr bool PERM = true;
    unsigned char* wsb;
    __device__ __forceinline__ void operator()(const f32x4 (&acc)[2][2][4][2], const Unit& u, int wr, int wc, int fr, int fq) const {
        const float* cosT = (const float*)(wsb + WS_COS); const float* sinT = (const float*)(wsb + WS_SIN);
        const int tsel = u.pn >> 2; bf16_t* base = (bf16_t*)(wsb + WS_PROJ) + (size_t)tsel * ((size_t)M * 1024);
        const int row0 = u.pm * BM + wr * 64 + fr, col0 = (u.pn & 3) * BM + wc * 32 + 8 * fq;
        const bool rope = (tsel == 3 || tsel == 4) && (wc == 0);
        const float sgn = (fq < 2) ? -1.f : 1.f; const int i0 = 8 * (fq & 1);
#pragma unroll
        for (int ai = 0; ai < 2; ++ai)
#pragma unroll
            for (int m = 0; m < 4; ++m) { const int row = row0 + ai * HALF + m * 16; bf16_t* rowp = base + (size_t)row * 1024 + col0;
                f32x4 c0 = (f32x4){1.f, 1.f, 1.f, 1.f}, c1 = c0, s0 = (f32x4){0.f, 0.f, 0.f, 0.f}, s1 = s0;
                if (rope) { const int pos = row & (SEQ - 1); c0 = *(const f32x4*)(cosT + pos * 16 + i0); c1 = *(const f32x4*)(cosT + pos * 16 + i0 + 4); s0 = *(const f32x4*)(sinT + pos * 16 + i0); s1 = *(const f32x4*)(sinT + pos * 16 + i0 + 4); }
#pragma unroll
                for (int bj = 0; bj < 2; ++bj) { f32x4 v0 = acc[ai][bj][m][0], v1 = acc[ai][bj][m][1];
                    if (rope) { f32x4 p0, p1;
#pragma unroll
                        for (int j = 0; j < 4; ++j) { p0[j] = __shfl_xor(v0[j], 32); p1[j] = __shfl_xor(v1[j], 32); }
                        v0 = v0 * c0 + (p0 * s0) * sgn; v1 = v1 * c1 + (p1 * s1) * sgn; }
                    u32x4 w; w.x = cvt_pk_bf16(v0[0], v0[1]); w.y = cvt_pk_bf16(v0[2], v0[3]); w.z = cvt_pk_bf16(v1[0], v1[1]); w.w = cvt_pk_bf16(v1[2], v1[3]);
                    *(u32x4*)(rowp + bj * HALF) = w; } }
    }
};
struct EpiRes {
    static constexpr bool PERM = false;
    const float* P; float* Qo; float alpha;
    __device__ __forceinline__ void operator()(const f32x4 (&acc)[2][2][4][2], const Unit& u, int wr, int wc, int fr, int fq) const {
        const int row0 = u.pm * BM + wr * 64 + fr, col0 = u.pn * BM + wc * 32 + 4 * fq;
#pragma unroll
        for (int ai = 0; ai < 2; ++ai)
#pragma unroll
            for (int m = 0; m < 4; ++m) { const size_t off = (size_t)(row0 + ai * HALF + m * 16) * DM + col0;
#pragma unroll
                for (int bj = 0; bj < 2; ++bj)
#pragma unroll
                    for (int n = 0; n < 2; ++n) { const f32x4 x = *(const f32x4*)(P + off + bj * HALF + n * 16); *(f32x4*)(Qo + off + bj * HALF + n * 16) = x * alpha + acc[ai][bj][m][n]; } }
    }
};
struct EpiSwiGLU {
    static constexpr bool PERM = true;
    bf16_t* H;
    __device__ __forceinline__ void operator()(const f32x4 (&acc)[2][2][4][2], const Unit& u, int wr, int wc, int fr, int fq) const {
        const int row0 = u.pm * BM + wr * 64 + fr, col0 = (u.pn & 3) * HALF + wc * 32 + 8 * fq;
#pragma unroll
        for (int ai = 0; ai < 2; ++ai)
#pragma unroll
            for (int m = 0; m < 4; ++m) { bf16_t* rowp = H + (size_t)(row0 + ai * HALF + m * 16) * DE + col0; float h[8];
#pragma unroll
                for (int n = 0; n < 2; ++n)
#pragma unroll
                    for (int j = 0; j < 4; ++j) { const float gg = acc[ai][0][m][n][j], uu = acc[ai][1][m][n][j];
                        h[n * 4 + j] = gg * uu * __builtin_amdgcn_rcpf(1.f + __builtin_amdgcn_exp2f(-1.4426950408889634f * gg)); }
                u32x4 w; w.x = cvt_pk_bf16(h[0], h[1]); w.y = cvt_pk_bf16(h[2], h[3]); w.z = cvt_pk_bf16(h[4], h[5]); w.w = cvt_pk_bf16(h[6], h[7]);
                *(u32x4*)rowp = w; }
    }
};
struct EpiDown {
    static constexpr bool PERM = true;
    bf16_t* Y;
    __device__ __forceinline__ void operator()(const f32x4 (&acc)[2][2][4][2], const Unit& u, int wr, int wc, int fr, int fq) const {
        const int row0 = u.pm * BM + wr * 64 + fr, col0 = (u.pn & 7) * BM + wc * 32 + 8 * fq;
#pragma unroll
        for (int ai = 0; ai < 2; ++ai)
#pragma unroll
            for (int m = 0; m < 4; ++m) { bf16_t* rowp = Y + (size_t)(row0 + ai * HALF + m * 16) * DM + col0;
#pragma unroll
                for (int bj = 0; bj < 2; ++bj) { const f32x4 v0 = acc[ai][bj][m][0], v1 = acc[ai][bj][m][1];
                    u32x4 w; w.x = cvt_pk_bf16(v0[0], v0[1]); w.y = cvt_pk_bf16(v0[2], v0[3]); w.z = cvt_pk_bf16(v1[0], v1[1]); w.w = cvt_pk_bf16(v1[2], v1[3]);
                    *(u32x4*)(rowp + bj * HALF) = w; } }
    }
};
}

namespace att {
using bf16 = __hip_bfloat16;
constexpr int D = 128, KP = 1024, OP = 2048;
constexpr float SCALE = 0.08838834764831845f;
constexpr float THR = 8.f;
constexpr int NW = 8, QBLK = 32, KVBLK = 64, QB = NW * QBLK;
constexpr int SHM_V = KVBLK * D * 2, SHM_K = KVBLK * D * 2;
constexpr int LDS_ATT = 2 * SHM_V + 2 * SHM_K + NW * 64 * 4;
constexpr int LDS_C = LDS_ATT, LDS_WT = LDS_C + SEQ * 4;
template <class A, class Bt> struct same_t { static constexpr bool v = false; };
template <class A> struct same_t<A, A> { static constexpr bool v = true; };
#define KSWZ(row, colB) ((row) * 256 + ((colB) ^ (((row) & 7) << 4)))
#define SBAR() __builtin_amdgcn_sched_barrier(0)
__device__ __forceinline__ int v_st(int k, int c) { const int kk = (k & ~0xC) | ((k & 4) << 1) | ((k & 8) >> 1); return ((kk >> 3) * 4 + (c >> 5)) * 512 + ((kk & 7) * 32 + (c & 31)) * 2; }
__device__ __forceinline__ int v_rd_base(int lane) { return ((lane & 3) << 3) | (((lane >> 2) & 3) << 6) | (((lane >> 4) & 1) << 5) | (((lane >> 5) & 1) << 8); }
constexpr int v_rd_off(int d0, int ks, int half) { return d0 * 512 + ks * 4096 + half * 2048; }
__device__ __forceinline__ int crow(int r, int hi) { return (r & 3) + 8 * (r >> 2) + 4 * hi; }
__device__ __forceinline__ unsigned cvtpk(float lo, float hi) { unsigned r; asm volatile("v_cvt_pk_bf16_f32 %0, %1, %2" : "=v"(r) : "v"(lo), "v"(hi)); return r; }
__device__ __forceinline__ bf16x8 load8(const bf16* p) { return *reinterpret_cast<const bf16x8*>(p); }
__device__ __forceinline__ void mask_tile(f32x16& p0, f32x16& p1, int dq, unsigned W) {
    const float NEG = -__builtin_inff();
#pragma unroll
    for (int r = 0; r < 16; ++r) {
        const int c = (r & 3) + 8 * (r >> 2);
        if ((unsigned)(dq - c) >= W) p0[r] = NEG;
        if ((unsigned)(dq - c - 32) >= W) p1[r] = NEG;
    }
}
__device__ __forceinline__ void partialSM(f32x16& p0, f32x16& p1, float& m_reg, float& mn, float& alpha) {
    float pmax = p0[0]; for (int r = 1; r < 16; ++r) pmax = fmaxf(pmax, p0[r]); for (int r = 0; r < 16; ++r) pmax = fmaxf(pmax, p1[r]);
    { auto rr = __builtin_amdgcn_permlane32_swap(__float_as_uint(pmax), __float_as_uint(pmax), false, false);
      pmax = fmaxf(__uint_as_float(rr[0]), __uint_as_float(rr[1])); }
    constexpr float C2 = 1.4426950408889634f * SCALE;
    if (__builtin_expect(__all((pmax - m_reg) * SCALE <= THR), 1)) { mn = m_reg; alpha = 1.f; }
    else { mn = fmaxf(m_reg, pmax); alpha = __builtin_amdgcn_exp2f((m_reg - mn) * C2); m_reg = mn; }
    const float mnL = -mn * C2;
    for (int r = 0; r < 16; ++r) p0[r] = fmaf(p0[r], C2, mnL); for (int r = 0; r < 16; ++r) p1[r] = fmaf(p1[r], C2, mnL);
    for (int r = 0; r < 16; ++r) p0[r] = __builtin_amdgcn_exp2f(p0[r]);
}
__device__ __forceinline__ void finishSM(f32x16& p0, f32x16& p1, float alpha, float& l_reg, bf16x8& pa0, bf16x8& pa1, bf16x8& pa2, bf16x8& pa3) {
    for (int r = 0; r < 16; ++r) p1[r] = __builtin_amdgcn_exp2f(p1[r]);
    float ps = 0; for (int r = 0; r < 16; ++r) ps += p0[r]; for (int r = 0; r < 16; ++r) ps += p1[r];
    { auto rr = __builtin_amdgcn_permlane32_swap(__float_as_uint(ps), __float_as_uint(ps), false, false);
      ps = __uint_as_float(rr[0]) + __uint_as_float(rr[1]); }
    l_reg = l_reg * alpha + ps;
#define PK4(P, B_, OUT) do { unsigned a0 = cvtpk(P[B_+0], P[B_+1]), a1 = cvtpk(P[B_+2], P[B_+3]);                          \
        unsigned b0 = cvtpk(P[B_+4], P[B_+5]), b1 = cvtpk(P[B_+6], P[B_+7]);                                             \
        auto r0 = __builtin_amdgcn_permlane32_swap(a0, b0, false, false); auto r1 = __builtin_amdgcn_permlane32_swap(a1, b1, false, false); \
        u32x4 w = {r0[0], r1[0], r0[1], r1[1]}; OUT = *reinterpret_cast<bf16x8*>(&w); } while (0)
    PK4(p0, 0, pa0); PK4(p0, 8, pa1); PK4(p1, 0, pa2); PK4(p1, 8, pa3);
#undef PK4
}
template <int KB, bool FOX>
__device__ __forceinline__ void qkt(f32x16& p0, f32x16& p1, const char* K_lds, int r32, int hi, const bf16x8* qr, const float* cb, float cqs) {
    if constexpr (FOX) { const f32x4* cp = (const f32x4*)cb + hi;
#pragma unroll
        for (int g = 0; g < 4; ++g) { const f32x4 a = cp[2 * g], b = cp[8 + 2 * g];
#pragma unroll
            for (int j = 0; j < 4; ++j) { p0[4 * g + j] = cqs - a[j]; p1[4 * g + j] = cqs - b[j]; } } }
    else { p0 = f32x16{}; p1 = f32x16{}; }
    const char* kb[4];
#pragma unroll
    for (int dd = 0; dd < 4; ++dd) kb[dd] = K_lds + KB * SHM_K + KSWZ(r32, (dd * 16 + hi * 8) * 2);
#pragma unroll
    for (int d0 = 0; d0 < 8; ++d0) { const char* a = kb[d0 & 3] + (d0 >> 2) * 128;
        bf16x8 b0 = *reinterpret_cast<const bf16x8*>(a);
        bf16x8 b1 = *reinterpret_cast<const bf16x8*>(a + 32 * 256);
        p0 = __builtin_amdgcn_mfma_f32_32x32x16_bf16(b0, qr[d0], p0, 0, 0, 0);
        p1 = __builtin_amdgcn_mfma_f32_32x32x16_bf16(b1, qr[d0], p1, 0, 0, 0); }
}
template <int VB>
__device__ __forceinline__ void pv_tile(f32x16* o, int vb0, bf16x8 pa0, bf16x8 pa1, bf16x8 pa2, bf16x8 pa3) {
#define TRRD(dst, off) asm volatile("ds_read_b64_tr_b16 %0, %1 offset:%2" : "=&v"(dst) : "v"(vb0), "i"(off) : "memory")
#define PV_D0(d0) do { s16x4 l0, l1, l2, l3, h0, h1, h2, h3; constexpr int b_ = VB * SHM_V + v_rd_off(d0, 0, 0); \
        TRRD(l0, b_); TRRD(h0, b_ + 2048); TRRD(l1, b_ + 4096); TRRD(h1, b_ + 6144); TRRD(l2, b_ + 8192); TRRD(h2, b_ + 10240); TRRD(l3, b_ + 12288); TRRD(h3, b_ + 14336); \
        asm volatile("s_waitcnt lgkmcnt(0)" ::: "memory"); SBAR();   \
        o[d0] = __builtin_amdgcn_mfma_f32_32x32x16_bf16(pa0, (bf16x8){l0[0], l0[1], l0[2], l0[3], h0[0], h0[1], h0[2], h0[3]}, o[d0], 0, 0, 0);   \
        o[d0] = __builtin_amdgcn_mfma_f32_32x32x16_bf16(pa1, (bf16x8){l1[0], l1[1], l1[2], l1[3], h1[0], h1[1], h1[2], h1[3]}, o[d0], 0, 0, 0);   \
        o[d0] = __builtin_amdgcn_mfma_f32_32x32x16_bf16(pa2, (bf16x8){l2[0], l2[1], l2[2], l2[3], h2[0], h2[1], h2[2], h2[3]}, o[d0], 0, 0, 0);   \
        o[d0] = __builtin_amdgcn_mfma_f32_32x32x16_bf16(pa3, (bf16x8){l3[0], l3[1], l3[2], l3[3], h3[0], h3[1], h3[2], h3[3]}, o[d0], 0, 0, 0); } while (0)
    PV_D0(0); PV_D0(1); PV_D0(2); PV_D0(3);
#undef PV_D0
#undef TRRD
}
template <class TOut> struct BlockRef { const bf16* Q; const bf16* K; const bf16* V; TOut* O; int P0; };
struct Seam { bf16x8 qr[8]; bf16x8 st_v0, st_v1, st_k0, st_k1; };
#define ROWB(p, k0, rr) ((const bf16*)((const char*)(p) + ((size_t)((k0) + (rr)) * KP * 2) + loff))
#define VMW() asm volatile("s_waitcnt vmcnt(0)" ::: "memory")
#define VMWN(n) asm volatile("s_waitcnt vmcnt(%0)" :: "i"(n) : "memory")
#define SLOAD_H(Kp, Vp, k0) do { S.st_v0 = load8(ROWB(Vp, k0, 0)); S.st_v1 = load8(ROWB(Vp, k0, 32));              \
                         S.st_k0 = load8(ROWB(Kp, k0, 0)); S.st_k1 = load8(ROWB(Kp, k0, 32)); } while (0)
#define SWRITE_HK(bf) do { *(bf16x8*)(K_lds + (bf) * SHM_K + kws) = S.st_k0; *(bf16x8*)(K_lds + (bf) * SHM_K + kws + 32 * 256) = S.st_k1; } while (0)
#define SWRITE_HV(bf) do { *(bf16x8*)(V_lds + (bf) * SHM_V + vst0) = S.st_v0; *(bf16x8*)(V_lds + (bf) * SHM_V + vst1) = S.st_v1; } while (0)
#define SWRITE_H(bf) do { SWRITE_HV(bf); SWRITE_HK(bf); } while (0)
template <class TOut>
__device__ __forceinline__ void prime(const BlockRef<TOut>& cur, char* lds, Seam& S) {
    const int tid = opaque_tid(), wid = __builtin_amdgcn_readfirstlane(tid >> 6), lane = tid & 63, r32 = lane & 31, hi = lane >> 5;
    const int sr = tid >> 4, sc = (tid & 15) * 8, kws = KSWZ(sr, sc * 2); char* K_lds = lds + 2 * SHM_V;
    const unsigned loff = (unsigned)(sr * KP + sc) * 2u, qoff = (unsigned)(r32 * KP + hi * 8) * 2u;
    { const char* qb_ = (const char*)cur.Q + (size_t)(wid * QBLK) * KP * 2;
#pragma unroll
    for (int d0 = 0; d0 < 8; ++d0) S.qr[d0] = load8((const bf16*)(qb_ + d0 * 32 + qoff)); }
    SLOAD_H(cur.K, cur.V, 0); VMW(); SWRITE_HK(0);
    __syncthreads();
}
template <class TOut, bool FOX>
__device__ __forceinline__ void block(const BlockRef<TOut>& cur, const BlockRef<TOut>& nxt, char* lds, Seam& S) {
    const int tid = opaque_tid(), wid = __builtin_amdgcn_readfirstlane(tid >> 6), lane = tid & 63, r32 = lane & 31, hi = lane >> 5;
    constexpr int W = SEQ;
    const int NT = (cur.P0 + QB - 1) / KVBLK + 1;
    const int qlo = cur.P0 + wid * QBLK, qm = qlo + r32 - 4 * hi;
    char* V_lds = lds; char* K_lds = lds + 2 * SHM_V;
    float* ws = (float*)(lds + 2 * SHM_V + 2 * SHM_K) + wid * 64; float* li_l = ws, * al_l = ws + 32;
    const float* c_l = (const float*)(lds + LDS_C);
    float cqs = 0.f; if constexpr (FOX) cqs = c_l[qlo + r32];
    float m_reg = -1e30f, l_reg = 0; f32x16 o[4] = {};
    const int sr = tid >> 4, sc = (tid & 15) * 8, vst0 = v_st(sr, sc), vst1 = v_st(32 + sr, sc), kws = KSWZ(sr, sc * 2);
    const unsigned loff = (unsigned)(sr * KP + sc) * 2u, qoff = (unsigned)(r32 * KP + hi * 8) * 2u;
    const int vb0 = (int)(uintptr_t)V_lds + v_rd_base(lane);
    const bf16* Kh = cur.K; const bf16* Vh = cur.V;
#define RESC(a) do { if (__any((a) < 1.f)) { if (hi == 0) al_l[r32] = (a); asm volatile("s_waitcnt lgkmcnt(0)" ::: "memory");              \
                     for (int d_ = 0; d_ < 4; ++d_) for (int r = 0; r < 16; ++r) o[d_][r] *= al_l[crow(r, hi)]; } } while (0)
#define KBASE(t) ((t) * KVBLK)
#define MASKT(P0_, P1_, t) do { const int kb_ = KBASE(t); if (kb_ + KVBLK - 1 > qlo) mask_tile(P0_, P1_, qm - kb_, (unsigned)W); } while (0)
    constexpr int NQL = 8;
#define SEAM_K0() do { VMWN(NQL); SWRITE_HK(0); SBAR(); } while (0)
    f32x16 pA0, pA1, pB0, pB1; float mnA, mnB, alA, alB; bf16x8 pa0, pa1, pa2, pa3;
    SWRITE_HV(0); SBAR();
    if (NT > 1) { SLOAD_H(Kh, Vh, KBASE(1)); }
    SBAR(); qkt<0, FOX>(pA0, pA1, K_lds, r32, hi, S.qr, c_l + KBASE(0), cqs);
    MASKT(pA0, pA1, 0); partialSM(pA0, pA1, m_reg, mnA, alA);
    if (NT > 1) { VMW(); SWRITE_H(1); }
    __syncthreads();
#define HALF_STEP(PX0, PX1, mnX, alX, PY0, PY1, alY, t, KB, VB, SB) do {                                                      \
        SBAR(); qkt<KB, FOX>(PX0, PX1, K_lds, r32, hi, S.qr, c_l + KBASE(t), cqs);                                          \
        finishSM(PY0, PY1, alY, l_reg, pa0, pa1, pa2, pa3); SBAR();                                                           \
        if ((t) + 1 < NT) { SLOAD_H(Kh, Vh, KBASE((t) + 1)); SBAR(); }                                                        \
        pv_tile<VB>(o, vb0, pa0, pa1, pa2, pa3); MASKT(PX0, PX1, (t)); partialSM(PX0, PX1, m_reg, mnX, alX);                \
        __syncthreads();                                                                                                      \
        if ((t) + 1 < NT) { VMW(); SWRITE_H(SB); }                                                                            \
        RESC(alX); __syncthreads(); } while (0)
    for (int t = 1; t + 1 < NT; t += 2) {
        HALF_STEP(pB0, pB1, mnB, alB, pA0, pA1, alA, t, 1, 0, 0);
        HALF_STEP(pA0, pA1, mnA, alA, pB0, pB1, alB, t + 1, 0, 1, 1);
    }
    const bool even = (NT & 1) == 0;
    if (even) { SBAR(); qkt<1, FOX>(pB0, pB1, K_lds, r32, hi, S.qr, c_l + KBASE(NT - 1), cqs); SBAR(); }
    SLOAD_H(nxt.K, nxt.V, 0); SBAR();
    { const char* qb_ = (const char*)nxt.Q + (size_t)(wid * QBLK) * KP * 2;
#pragma unroll
    for (int d0 = 0; d0 < 8; ++d0) S.qr[d0] = load8((const bf16*)(qb_ + d0 * 32 + qoff)); }
    SBAR();
    finishSM(pA0, pA1, alA, l_reg, pa0, pa1, pa2, pa3); SBAR();
    pv_tile<0>(o, vb0, pa0, pa1, pa2, pa3);
    if (even) { MASKT(pB0, pB1, NT - 1); partialSM(pB0, pB1, m_reg, mnB, alB); __syncthreads(); RESC(alB);
        finishSM(pB0, pB1, alB, l_reg, pa0, pa1, pa2, pa3); SBAR(); pv_tile<1>(o, vb0, pa0, pa1, pa2, pa3); }
    SBAR(); SEAM_K0();
    if (hi == 0) li_l[r32] = l_reg; asm volatile("s_waitcnt lgkmcnt(0)" ::: "memory");
    float rli[16];
#pragma unroll
    for (int r = 0; r < 16; ++r) rli[r] = __builtin_amdgcn_rcpf(li_l[crow(r, hi)]);
    char* Ow = (char*)(cur.O + (size_t)(wid * QBLK) * OP);
    const unsigned ooff = (unsigned)(4 * hi * OP + r32) * (unsigned)sizeof(TOut);
#pragma unroll
    for (int r = 0; r < 16; ++r) { char* Or = Ow + (size_t)((r & 3) + 8 * (r >> 2)) * OP * sizeof(TOut);
#pragma unroll
        for (int d0 = 0; d0 < 4; ++d0) { const float v = o[d0][r] * rli[r];
            if constexpr (same_t<TOut, float>::v) { *(float*)(Or + d0 * 32 * 4 + ooff) = v; }
            else { const float vn = __shfl_xor(v, 1);
                   if ((r32 & 1) == 0) *(unsigned*)(Or + d0 * 32 * 2 + ooff) = cvtpk(v, vn); } } }
    __syncthreads();
#undef RESC
#undef KBASE
#undef MASKT
#undef SEAM_K0
#undef HALF_STEP
}
#undef ROWB
#undef VMW
#undef VMWN
#undef SLOAD_H
#undef SWRITE_HK
#undef SWRITE_HV
#undef SWRITE_H
#undef KSWZ
#undef SBAR
__device__ __forceinline__ void fox_load_c(const float* logf_bh, char* lds, int tid) {
    const int lane = tid & 63, wid = tid >> 6;
    float* c_l = (float*)(lds + LDS_C); float* wt = (float*)(lds + LDS_WT);
    f32x4 v[4]; const f32x4* src = (const f32x4*)(logf_bh + 16 * tid);
#pragma unroll
    for (int i = 0; i < 4; ++i) v[i] = src[i];
    float run = 0.f;
#pragma unroll
    for (int i = 0; i < 4; ++i)
#pragma unroll
        for (int j = 0; j < 4; ++j) { run += v[i][j]; v[i][j] = run; }
    float inc = run;
#pragma unroll
    for (int o = 1; o < 64; o <<= 1) { const float t = __shfl_up(inc, o); if (lane >= o) inc += t; }
    if (lane == 63) wt[wid] = inc;
    __syncthreads();
    float base = inc - run;
    for (int w = 0; w < wid; ++w) base += wt[w];
    const float RS = 11.313708498984761f;
#pragma unroll
    for (int i = 0; i < 4; ++i) { f32x4 o;
#pragma unroll
        for (int j = 0; j < 4; ++j) o[j] = (v[i][j] + base) * RS;
        *(f32x4*)(c_l + 16 * tid + 4 * i) = o; }
}
}

#define XB_TMO      128
#define XB_XCNT(j)  (256  + 64 * (j))
#define XB_XSUB(j)  (1280 + 64 * (j))
#define XB_XGEN(j)  (2304 + 64 * (j))
#define XB_TOP      3328
#define XB_TOPGEN   3392
#define XCD_BAR_WORDS 3456
#define XB_SPIN_CAP (1u << 18)
__device__ __forceinline__ unsigned xb_ld(unsigned* p)              { return __hip_atomic_load(p, __ATOMIC_RELAXED, __HIP_MEMORY_SCOPE_AGENT); }
__device__ __forceinline__ unsigned xb_add(unsigned* p, unsigned v) { return __hip_atomic_fetch_add(p, v, __ATOMIC_RELAXED, __HIP_MEMORY_SCOPE_AGENT); }
__device__ __forceinline__ unsigned xb_xcc_id() { return (unsigned)__builtin_amdgcn_s_getreg((3 << 11) | 20) & 0xFu; }
#define XB_SPIN(cond, bar) do { unsigned _sp = 0; while (cond) { __builtin_amdgcn_s_sleep(1); \
    if ((++_sp & 255u) == 0u) { if (xb_ld(&(bar)[XB_TMO])) break; if (_sp > XB_SPIN_CAP) { atomicAdd(&(bar)[XB_TMO], 1u); break; } } } } while (0)
struct XcdBarrier { unsigned* bar; unsigned x; volatile LAS unsigned* st; };
__device__ __forceinline__ XcdBarrier xcd_barrier_post(unsigned* bar, volatile LAS unsigned* st) {
    XcdBarrier b; b.bar = bar; b.x = xb_xcc_id(); b.st = st;
    if (threadIdx.x == 0) (void)xb_add(&bar[XB_XCNT(b.x)], 1u);
    return b;
}
__device__ __forceinline__ void xcd_barrier_complete(unsigned* bar, unsigned x, unsigned& nloc, unsigned& nx) {
    const unsigned G = gridDim.x * gridDim.y * gridDim.z;
    unsigned sum, cnt, mine, sp = 0u;
    for (;;) {
        sum = 0u; cnt = 0u; mine = 0u;
#pragma unroll
        for (unsigned j = 0; j < 16; ++j) { const unsigned c = xb_ld(&bar[XB_XCNT(j)]); sum += c; cnt += (c > 0u) ? 1u : 0u; mine = (j == x) ? c : mine; }
        if (sum == G) break;
        __builtin_amdgcn_s_sleep(1);
        if ((++sp & 255u) == 0u) { if (xb_ld(&bar[XB_TMO])) break; if (sp > XB_SPIN_CAP) { atomicAdd(&bar[XB_TMO], 1u); break; } }
    }
    nloc = mine > 0u ? mine : 1u; nx = cnt > 0u ? cnt : 1u;
}
__device__ __forceinline__ void xcd_barrier(const XcdBarrier& b) {
    asm volatile("s_waitcnt vmcnt(0)" ::: "memory");
    __syncthreads();
    if (threadIdx.x == 0) {
        unsigned* bar = b.bar;
        __builtin_amdgcn_s_waitcnt(0);
        unsigned nloc = b.st[0], nx = b.st[1];
        if (nloc == 0u) { xcd_barrier_complete(bar, b.x, nloc, nx); b.st[0] = nloc; b.st[1] = nx; }
        const unsigned old = xb_add(&bar[XB_XSUB(b.x)], 1u);
        const unsigned gen = old / nloc;
        if (old + 1u == (gen + 1u) * nloc) {
            __builtin_amdgcn_fence(__ATOMIC_RELEASE, "agent");
            asm volatile("s_waitcnt vmcnt(0)" ::: "memory");
            const unsigned og = xb_add(&bar[XB_TOP], 1u);
            const unsigned tg = og / nx;
            if (og + 1u == (tg + 1u) * nx) xb_add(&bar[XB_TOPGEN], 1u);
            else XB_SPIN(xb_ld(&bar[XB_TOPGEN]) == tg, bar);
            __builtin_amdgcn_fence(__ATOMIC_ACQUIRE, "agent");
            xb_add(&bar[XB_XGEN(b.x)], 1u);
            asm volatile("s_waitcnt vmcnt(0)" ::: "memory");
        } else {
            XB_SPIN(xb_ld(&bar[XB_XGEN(b.x)]) == gen, bar);
            __builtin_amdgcn_fence(__ATOMIC_ACQUIRE, "agent");
            asm volatile("s_waitcnt vmcnt(0)" ::: "memory");
        }
    }
    __syncthreads();
}

struct Args { const float* in[17]; float* out; unsigned char* ws; int ph_lo, ph_hi; };
enum { I_X = 0, I_WIN, I_BF, I_DLAM, I_SUBG, I_WO, I_LN1G, I_LN1B, I_WRG, I_BRG, I_WRE, I_BRE, I_WG, I_WU, I_WDN, I_LN2G, I_LN2B };

__device__ __forceinline__ void transpose_item(const float* src, int ldw, bf16_t* dst, int ldd, LAS float* scr, int lane) {
#pragma unroll 8
    for (int i = 0; i < 32; ++i) { const int kk = 2 * i + (lane >> 5); scr[kk * 33 + (lane & 31)] = src[(size_t)kk * ldw + (lane & 31)]; }
    LDS_WAIT(); asm volatile("" ::: "memory");
    const int c = lane & 7;
#pragma unroll
    for (int j = 0; j < 4; ++j) { const int n = (lane >> 3) + 8 * j; const LAS float* s = scr + (8 * c) * 33 + n;
        u32x4 o; o.x = pk2(s[0 * 33], s[1 * 33]); o.y = pk2(s[2 * 33], s[3 * 33]); o.z = pk2(s[4 * 33], s[5 * 33]); o.w = pk2(s[6 * 33], s[7 * 33]);
        *(GAS u32x4*)(dst + (size_t)n * ldd + 8 * c) = o; }
    LDS_WAIT(); asm volatile("" ::: "memory");
}

template <int NT>
__device__ __forceinline__ void skinny_logits(const bf16_t* X, const bf16_t* Wt, LAS float* part, LAS float* logits, int tid) {
    const int lane = tid & 63, wid = __builtin_amdgcn_readfirstlane(tid >> 6), r = lane & 15, kq = lane >> 4;
    f32x4 acc[4][NT];
#pragma unroll
    for (int mt = 0; mt < 4; ++mt)
#pragma unroll
        for (int nt = 0; nt < NT; ++nt) acc[mt][nt] = (f32x4){0.f, 0.f, 0.f, 0.f};
    const bf16_t* ap = X + (size_t)r * DM + wid * 256 + kq * 8;
    const bf16_t* bp = Wt + (size_t)r * DM + wid * 256 + kq * 8;
#pragma unroll 2
    for (int ks = 0; ks < 8; ++ks) {
        bf16x8 a[4], b[NT];
#pragma unroll
        for (int mt = 0; mt < 4; ++mt) a[mt] = *(const GAS bf16x8*)(ap + (size_t)mt * 16 * DM + ks * 32);
#pragma unroll
        for (int nt = 0; nt < NT; ++nt) b[nt] = *(const GAS bf16x8*)(bp + (size_t)nt * 16 * DM + ks * 32);
#pragma unroll
        for (int mt = 0; mt < 4; ++mt)
#pragma unroll
            for (int nt = 0; nt < NT; ++nt) acc[mt][nt] = __builtin_amdgcn_mfma_f32_16x16x32_bf16(a[mt], b[nt], acc[mt][nt], 0, 0, 0);
    }
    constexpr int LW = 16 * NT;
#pragma unroll
    for (int mt = 0; mt < 4; ++mt)
#pragma unroll
        for (int nt = 0; nt < NT; ++nt)
#pragma unroll
            for (int g = 0; g < 4; ++g) part[(wid * 64 + mt * 16 + 4 * kq + g) * LW + nt * 16 + r] = acc[mt][nt][g];
    __syncthreads();
    for (int o = tid; o < 64 * LW; o += 512) { float s = 0.f;
#pragma unroll
        for (int w = 0; w < 8; ++w) s += part[w * 64 * LW + o];
        logits[o] = s; }
    __syncthreads();
}

__device__ __forceinline__ att::BlockRef<att::bf16> fox_ref(int L, int pass, const bf16_t* FQ, const bf16_t* FK, const bf16_t* FV, bf16_t* MRG) {
    const int bh = L >> 4, x = L & 15, qb = pass ? 31 - x : x, b = bh >> 3, h = bh & 7;
    const size_t rowb = (size_t)b * SEQ; att::BlockRef<att::bf16> r;
    r.Q = (const att::bf16*)FQ + (rowb + (size_t)qb * 256) * att::KP + h * HD; r.K = (const att::bf16*)FK + rowb * att::KP + h * HD; r.V = (const att::bf16*)FV + rowb * att::KP + h * HD;
    r.O = (att::bf16*)MRG + (rowb + (size_t)qb * 256) * att::OP + h * HD; r.P0 = qb * 256; return r;
}
__device__ __forceinline__ att::BlockRef<float> dif_ref(int L, int pass, const bf16_t* DQ, const bf16_t* DK, const bf16_t* DV, float* OD) {
    const int vh = L >> 4, x = L & 15, qb = pass ? 31 - x : x, v = vh & 1, j = (vh >> 1) & 1, h = (vh >> 2) & 3, b = vh >> 4;
    const size_t rowb = (size_t)b * SEQ; att::BlockRef<float> r;
    r.Q = (const att::bf16*)DQ + (rowb + (size_t)qb * 256) * att::KP + (2 * h + j) * HD; r.K = (const att::bf16*)DK + rowb * att::KP + (2 * h + j) * HD;
    r.V = (const att::bf16*)DV + rowb * att::KP + h * 256 + v * HD;
    r.O = OD + (rowb + (size_t)qb * 256) * att::OP + h * 512 + j * 256 + v * HD; r.P0 = qb * 256; return r;
}

__global__ void __launch_bounds__(512, 2) trunk_fwd(Args args) {
    extern __shared__ __attribute__((aligned(16))) unsigned char lds_raw[];
    LAS unsigned char* lds = (LAS unsigned char*)lds_raw;
    const int G = gridDim.x, bx = blockIdx.x;
    const int vcu = (G % 8 == 0) ? (bx % 8) * (G / 8) + bx / 8 : bx;
    volatile LAS unsigned* MISC = (volatile LAS unsigned*)(lds + MISC_OFF);
    if (threadIdx.x < 32) MISC[threadIdx.x] = 0u;
    __syncthreads();
#define PHASE_LOCALS const int tid = opaque_tid(), lane = tid & 63, wave = __builtin_amdgcn_readfirstlane(tid >> 6); unsigned char* ws = opaque_ptr(args.ws); unsigned* ctl = (unsigned*)(ws + WS_CTL); (void)lane; (void)wave; (void)ctl;
    const int lo = args.ph_lo, hi = args.ph_hi;
    const bool use_bar = (hi - lo) > 1;
    XcdBarrier bar; bar.bar = (unsigned*)(args.ws + WS_CTL) + CW_BAR; bar.x = 0; bar.st = nullptr;
    if (use_bar) bar = xcd_barrier_post((unsigned*)(args.ws + WS_CTL) + CW_BAR, MISC + 8);
#ifndef PH_MASK
#define PH_MASK 0x1ff
#endif
#define PHK(k) ((k) == 0 ? 0 : (((k) - 1) % 8) + 1)
#define IN(k) (((PH_MASK >> PHK(k)) & 1) && lo <= (k) && (k) < hi)
#define BOTH(k) (IN(k) && IN((k) + 1))
#define GRID_BAR() do { xcd_barrier(bar); } while (0)

#define WIN_T ((bf16_t*)(ws + WS_WIN))
#define WO_T ((bf16_t*)(ws + WS_WO))
#define WGU_T ((bf16_t*)(ws + WS_WGU))
#define WD_T ((bf16_t*)(ws + WS_WD))
#define WF_T ((bf16_t*)(ws + WS_WF))
#define WR_T ((bf16_t*)(ws + WS_WR))
#define COS ((float*)(ws + WS_COS))
#define SIN ((float*)(ws + WS_SIN))
#define LOGF ((float*)(ws + WS_LOGF))
#define TOK ((unsigned*)(ws + WS_TOK))
#define LIST ((int*)(ws + WS_LIST))
#define PB ((float*)(ws + WS_P))
#define QBUF ((float*)(ws + WS_Q))
#define XB ((bf16_t*)(ws + WS_XB))
#define PROJ ((bf16_t*)(ws + WS_PROJ))
#define MRG ((bf16_t*)(ws + WS_MRG))
#define OD ((float*)(ws + WS_OD))
#define HID ((bf16_t*)(ws + WS_HID))
#define YS ((bf16_t*)(ws + WS_YS))
    constexpr size_t PSTR = (size_t)M * 1024;
#define FQ (PROJ)
#define FK (PROJ + PSTR)
#define FV (PROJ + 2 * PSTR)
#define DQ (PROJ + 3 * PSTR)
#define DK (PROJ + 4 * PSTR)
#define DV (PROJ + 5 * PSTR)
    LAS int* utab = (LAS int*)(lds + T_UTAB); LAS unsigned* rowtab = (LAS unsigned*)(lds + T_ROWTAB);
#define x_in (args.in[I_X])
#define FILL_STATIC(Mr, Nc) do { if (tid < 64) { pg8::StaticOrder SO; SO.init(Mr, Nc, G, bx); pg8::Unit u_; u_.pm = 0; u_.pn = 0; const bool ok_ = (tid < 8) && SO.next(tid, u_); \
        if (tid < 8) { utab[2 * tid] = u_.pm; utab[2 * tid + 1] = u_.pn; } const unsigned long long m_ = __ballot(ok_); if (tid == 0) ((LAS int*)(lds + T_MISC))[1] = __popcll(m_); } __syncthreads(); } while (0)
#define FILL_GROUPED(U_, sh_) do { if (tid < 64) { pg8::Unit u_; u_.pm = 0; u_.pn = 0; const bool ok_ = (tid < 8) && pg8::grouped_unit(U_, bx % 8, bx / 8, G / 8, sh_, chunk_e, tid, u_); \
        if (tid < 8) { utab[2 * tid] = u_.pm; utab[2 * tid + 1] = u_.pn; } const unsigned long long m_ = __ballot(ok_); if (tid == 0) tmisc[1] = __popcll(m_); } __syncthreads(); } while (0)
    if (IN(0)) {
        PHASE_LOCALS
        LAS float* scr = (LAS float*)(lds + wave * 16384);
        const int gw = vcu * 8 + wave, NGW = G * 8;
        constexpr int I_A = DEPTH * 32 * 192, I_B = DEPTH * 32 * 64, I_C = DEPTH * NE * 32 * 16, I_E = DEPTH * NE * 8 * 64;
        constexpr int NITEMS = I_A + I_B + 2 * I_C + I_E;
        for (int it = gw; it < NITEMS; it += NGW) {
            int r = it;
            if (r < I_A) { const int l = r / (32 * 192), rem = r % (32 * 192), kb = rem / 192, nb = rem % 192; const int n0 = 32 * nb, sc0 = n0 + (n0 >= 3072 ? 8 : 0);
                transpose_item(args.in[I_WIN] + (size_t)l * DM * INW + (size_t)(64 * kb) * INW + sc0, INW, WIN_T + (size_t)l * NPROJ * DM + (size_t)n0 * DM + 64 * kb, DM, scr, lane); continue; }
            r -= I_A;
            if (r < I_B) { const int l = r / (32 * 64), rem = r % (32 * 64), kb = rem / 64, nb = rem % 64;
                transpose_item(args.in[I_WO] + (size_t)l * DM * DM + (size_t)(64 * kb) * DM + 32 * nb, DM, WO_T + (size_t)l * DM * DM + (size_t)(32 * nb) * DM + 64 * kb, DM, scr, lane); continue; }
            r -= I_B;
            if (r < 2 * I_C) { const int up = r >= I_C ? 1 : 0; if (up) r -= I_C; const int le = r / 512, rem = r % 512, kb = rem / 16, nb = rem % 16;
                const float* src = (up ? args.in[I_WU] : args.in[I_WG]) + (size_t)le * DM * DE + (size_t)(64 * kb) * DE + 32 * nb;
                const int drow = 256 * (nb >> 2) + 32 * (nb & 3) + 128 * up;
                transpose_item(src, DE, WGU_T + (size_t)le * 1024 * DM + (size_t)drow * DM + 64 * kb, DM, scr, lane); continue; }
            r -= 2 * I_C;
            { const int le = r / 512, rem = r % 512, kb = rem / 64, nb = rem % 64;
                transpose_item(args.in[I_WDN] + (size_t)le * DE * DM + (size_t)(64 * kb) * DM + 32 * nb, DM, WD_T + (size_t)le * DM * DE + (size_t)(32 * nb) * DE + 64 * kb, DE, scr, lane); }
        }
        const int gt = vcu * 512 + tid, NGT = G * 512;
        for (int idx = gt; idx < DEPTH * 16 * DM; idx += NGT) { const int l = idx / (16 * DM), rem = idx % (16 * DM), n = rem / DM, k = rem % DM;
            const float v = (n < 8) ? args.in[I_WIN][(size_t)l * DM * INW + (size_t)k * INW + 3072 + n] : 0.f; WF_T[idx] = (bf16_t)f2bf(v); }
        for (int idx = gt; idx < DEPTH * 48 * DM; idx += NGT) { const int l = idx / (48 * DM), rem = idx % (48 * DM), n = rem / DM, k = rem % DM;
            float v = 0.f; if (n < 4) v = args.in[I_WRG][(size_t)l * DM * 4 + (size_t)k * 4 + n]; else if (n < 36) v = args.in[I_WRE][(size_t)l * DM * 32 + (size_t)k * 32 + (n - 4)];
            WR_T[idx] = (bf16_t)f2bf(v); }
        for (int idx = gt; idx < SEQ * 16; idx += NGT) { const int pos = idx >> 4, i = idx & 15;
            const double inv = pow(500000.0, -(double)i * (1.0 / 16.0));
            const double ang = (double)pos * inv; COS[idx] = (float)cos(ang); SIN[idx] = (float)sin(ang); }
        for (int idx = gt; idx < M * DM / 8; idx += NGT) { const f32x4 a = *(const GAS f32x4*)(x_in + (size_t)idx * 8), b = *(const GAS f32x4*)(x_in + (size_t)idx * 8 + 4);
            u32x4 w; w.x = pk2(a[0], a[1]); w.y = pk2(a[2], a[3]); w.z = pk2(b[0], b[1]); w.w = pk2(b[2], b[3]); *(GAS u32x4*)(XB + (size_t)idx * 8) = w; }
        if (BOTH(0)) GRID_BAR();
    }

    for (int l = 0; l < DEPTH; ++l) {
        const int pb = 1 + 8 * l;
        const float lam_init = 0.8f - 0.6f * expf(-0.3f * (float)l);
#define Pin ((l == 0) ? x_in : (const float*)PB)
#define Pout ((l == DEPTH - 1) ? args.out : PB)
#define cnt (ctl + CW_CNT + l * 32 * 16)

        if (IN(pb + 0)) {
            PHASE_LOCALS
            LAS float* part = (LAS float*)(lds + 16384); LAS float* logits = (LAS float*)(lds + 114688);
            for (int tile = bx; tile < M / 64; tile += G) {
                skinny_logits<1>(XB + (size_t)tile * 64 * DM, WF_T + (size_t)l * 16 * DM, part, logits, tid);
                if (tid < 64) { const int token = tile * 64 + tid, b = token / SEQ, pos = token % SEQ;
#pragma unroll
                    for (int h = 0; h < 8; ++h) { const float z = logits[tid * 16 + h] + args.in[I_BF][l * 8 + h];
                        const float lf = fminf(z, 0.f) - log1pf(__expf(-fabsf(z)));
                        LOGF[(size_t)(b * 8 + h) * SEQ + pos] = lf; } }
                __syncthreads();
            }
            FILL_STATIC(M, NPROJ);
            pg8::Gemm g{XB, WIN_T + (size_t)l * NPROJ * DM, DM}; pg8::TabOrder S{((LAS int*)(lds + T_MISC))[1], utab, rowtab};
            pg8::EpiInProj E{ws};
            pg8::gemm_phase<pg8::EpiInProj, pg8::TabOrder, false>(lds, g, S, E);
            if (BOTH(pb + 0)) GRID_BAR();
        }

        if (IN(pb + 1)) {
            PHASE_LOCALS
            char* alds = (char*)lds_raw;
#ifndef NO_FOX
            {
                typedef att::BlockRef<att::bf16> BR;
                constexpr int TOTAL = BATCH * FOXH * 16;
                int L = vcu;
                if (L < TOTAL) {
                    int pass = 0; BR cur = fox_ref(L, 0, FQ, FK, FV, MRG); att::Seam S; att::prime<att::bf16>(cur, alds, S);
                    for (;;) {
                        if (pass == 0) { att::fox_load_c(LOGF + (size_t)(L >> 4) * SEQ, alds, tid); __syncthreads(); }
                        const bool more_pass = pass == 0, more_item = L + G < TOTAL, last = !more_pass && !more_item;
                        const int passn = more_pass ? 1 : 0, Ln = more_pass ? L : (more_item ? L + G : L);
                        const BR nxt = last ? cur : fox_ref(Ln, passn, FQ, FK, FV, MRG);
                        att::block<att::bf16, true>(cur, nxt, alds, S);
                        if (last) break;
                        cur = nxt; pass = passn; L = Ln;
                    }
                }
            }
#endif
#ifndef NO_DIF
            {
                typedef att::BlockRef<float> BR;
                constexpr int TOTAL = BATCH * DIFH * 4 * 16;
                int L = vcu;
                if (L < TOTAL) {
                    int pass = 0; BR cur = dif_ref(L, 0, DQ, DK, DV, OD); att::Seam S; att::prime<float>(cur, alds, S);
                    for (;;) {
                        const bool more_pass = pass == 0, more_item = L + G < TOTAL, last = !more_pass && !more_item;
                        const int passn = more_pass ? 1 : 0, Ln = more_pass ? L : (more_item ? L + G : L);
                        const BR nxt = last ? cur : dif_ref(Ln, passn, DQ, DK, DV, OD);
                        att::block<float, false>(cur, nxt, alds, S);
                        if (last) break;
                        cur = nxt; pass = passn; L = Ln;
                    }
                }
            }
#endif
            if (BOTH(pb + 1)) GRID_BAR();
        }

        if (IN(pb + 2)) {
            PHASE_LOCALS
            const float* lv = args.in[I_DLAM] + l * 4 * HD;
            float d1 = lv[lane] * lv[HD + lane] + lv[64 + lane] * lv[HD + 64 + lane], d2 = lv[2 * HD + lane] * lv[3 * HD + lane] + lv[2 * HD + 64 + lane] * lv[3 * HD + 64 + lane];
            d1 = wave_sum(d1); d2 = wave_sum(d2);
            const float lam = __expf(d1) - __expf(d2) + lam_init;
            const f32x4 gsub = *(const f32x4*)(args.in[I_SUBG] + l * 256 + 4 * lane);
            const float osc = 1.f - lam_init;
            const int gw = vcu * 8 + wave, NGW = G * 8;
            for (int task = gw; task < M * DIFH; task += NGW) { const int row = task >> 2, h = task & 3;
                const float* src = OD + (size_t)row * 2048 + h * 512 + 4 * lane;
                const f32x4 o1 = *(const GAS f32x4*)src, o2 = *(const GAS f32x4*)(src + 256);
                const f32x4 d = o1 - o2 * lam;
                const float ss = wave_sum((d[0] * d[0] + d[1] * d[1]) + (d[2] * d[2] + d[3] * d[3]));
                const float rs = (1.0f / sqrtf(ss * (1.f / 256.f) + RMS_EPS)) * osc;
                const f32x4 y = d * gsub * rs;
                u32x2 w; w.x = cvt_pk_bf16(y[0], y[1]); w.y = cvt_pk_bf16(y[2], y[3]);
                *(GAS u32x2*)(MRG + (size_t)row * DM + 1024 + h * 256 + 4 * lane) = w; }
            if (BOTH(pb + 2)) GRID_BAR();
        }

        if (IN(pb + 3)) {
            PHASE_LOCALS
            FILL_STATIC(M, DM);
            pg8::Gemm g{MRG, WO_T + (size_t)l * DM * DM, DM}; pg8::TabOrder S{((LAS int*)(lds + T_MISC))[1], utab, rowtab};
            pg8::EpiRes E{Pin, QBUF, ALPHA};
            pg8::gemm_phase<pg8::EpiRes, pg8::TabOrder, false>(lds, g, S, E);
            if (BOTH(pb + 3)) GRID_BAR();
        }

        if (IN(pb + 4)) {
            PHASE_LOCALS
            LAS float* gl = (LAS float*)lds; LAS float* bl = (LAS float*)(lds + 8192);
            LAS float* part = (LAS float*)(lds + 16384); LAS float* logits = (LAS float*)(lds + 114688);
            LAS int* hist = (LAS int*)(lds + T_HIST); LAS int* basee = (LAS int*)(lds + T_BASE);
            for (int i = tid; i < DM; i += 512) { gl[i] = args.in[I_LN1G][l * DM + i]; bl[i] = args.in[I_LN1B][l * DM + i]; }
            __syncthreads();
            for (int tile = bx; tile < M / 64; tile += G) {
                for (int rr = 0; rr < 8; ++rr) { const int row = tile * 64 + wave * 8 + rr;
                    GAS f32x4* xr = (GAS f32x4*)(QBUF + (size_t)row * DM) + lane;
                    f32x4 v[8]; float s = 0.f;
#pragma unroll
                    for (int j = 0; j < 8; ++j) { v[j] = xr[64 * j]; s += (v[j][0] + v[j][1]) + (v[j][2] + v[j][3]); }
                    const float mean = wave_sum(s) * (1.f / DM); float s2 = 0.f;
#pragma unroll
                    for (int j = 0; j < 8; ++j) { v[j] = v[j] - mean; s2 += (v[j][0] * v[j][0] + v[j][1] * v[j][1]) + (v[j][2] * v[j][2] + v[j][3] * v[j][3]); }
                    const float rstd = 1.f / sqrtf(wave_sum(s2) * (1.f / DM) + LN_EPS);
                    GAS u32x2* o8 = (GAS u32x2*)(XB + (size_t)row * DM) + lane;
#pragma unroll
                    for (int j = 0; j < 8; ++j) { const f32x4 gg = *(const LAS f32x4*)(gl + 256 * j + 4 * lane), bb = *(const LAS f32x4*)(bl + 256 * j + 4 * lane);
                        const f32x4 y = v[j] * rstd * gg + bb; xr[64 * j] = y;
                        u32x2 w; w.x = cvt_pk_bf16(y[0], y[1]); w.y = cvt_pk_bf16(y[2], y[3]); o8[64 * j] = w; }
                }
                if (tid < 32) hist[tid] = 0;
                VM_WAIT(); __syncthreads();
                skinny_logits<3>(XB + (size_t)tile * 64 * DM, WR_T + (size_t)l * 48 * DM, part, logits, tid);
                int e0 = 0, e1 = 0, lr0 = 0, lr1 = 0; float w0 = 0.f, w1 = 0.f;
                if (tid < 64) {
                    const LAS float* lg = logits + tid * 48;
                    float gv[4]; int gs = 0; float gm;
#pragma unroll
                    for (int q = 0; q < 4; ++q) gv[q] = lg[q] + args.in[I_BRG][l * 4 + q];
                    gm = gv[0];
#pragma unroll
                    for (int q = 1; q < 4; ++q) if (gv[q] > gm) { gm = gv[q]; gs = q; }
                    float gsum = 0.f;
#pragma unroll
                    for (int q = 0; q < 4; ++q) gsum += __expf(gv[q] - gm);
                    const float gw_ = 1.f / gsum;
                    float ev[8];
#pragma unroll
                    for (int q = 0; q < 8; ++q) ev[q] = lg[4 + gs * 8 + q] + args.in[I_BRE][l * 32 + gs * 8 + q];
                    int ia = 0; float va = ev[0];
#pragma unroll
                    for (int q = 1; q < 8; ++q) if (ev[q] > va) { va = ev[q]; ia = q; }
                    int ib = -1; float vb = -3.0e38f;
#pragma unroll
                    for (int q = 0; q < 8; ++q) if (q != ia && ev[q] > vb) { vb = ev[q]; ib = q; }
                    const float eb = __expf(vb - va), den = 1.f / (1.f + eb);
                    w0 = gw_ * den; w1 = gw_ * eb * den;
                    e0 = gs * 8 + ia; e1 = gs * 8 + ib;
                    lr0 = __hip_atomic_fetch_add(&hist[e0], 1, __ATOMIC_RELAXED, __HIP_MEMORY_SCOPE_WORKGROUP); lr1 = __hip_atomic_fetch_add(&hist[e1], 1, __ATOMIC_RELAXED, __HIP_MEMORY_SCOPE_WORKGROUP);
                }
                __syncthreads();
                if (tid < 32) { const int n = hist[tid]; int b0 = 0; if (n > 0) b0 = (int)__hip_atomic_fetch_add(cnt + tid * 16, (unsigned)n, RLX_AGENT); basee[tid] = b0; }
                __syncthreads();
                if (tid < 64) { const int token = tile * 64 + tid; const int r0 = basee[e0] + lr0, r1 = basee[e1] + lr1;
                    LIST[e0 * M + r0] = token; LIST[e1 * M + r1] = token;
                    u32x4 ta; ta.x = (unsigned)e0; ta.y = (unsigned)r0; ta.z = (unsigned)e1; ta.w = (unsigned)r1;
                    u32x4 tb; tb.x = __float_as_uint(w0); tb.y = __float_as_uint(w1); tb.z = 0u; tb.w = 0u;
                    *(GAS u32x4*)(TOK + (size_t)token * 8) = ta; *(GAS u32x4*)(TOK + (size_t)token * 8 + 4) = tb; }
                __syncthreads();
            }
            if (BOTH(pb + 4)) GRID_BAR();
        }

        if (IN(pb + 5) || IN(pb + 6)) {
            PHASE_LOCALS
            LAS int* chunk_e = (LAS int*)(lds + T_CHUNK_E); LAS int* tmisc = (LAS int*)(lds + T_MISC);
            LAS int* pstart = (LAS int*)(lds + T_PSTART);
            if (tid == 0) { int C = 0;
_Pragma("nounroll")
                for (int e = 0; e < NE; ++e) { const int n = (int)__hip_atomic_load(cnt + e * 16, RLX_AGENT); const int nch = (n + 255) >> 8; pstart[e] = C;
_Pragma("nounroll")
                    for (int c = 0; c < nch; ++c) chunk_e[C + c] = e; C += nch; } tmisc[0] = C; }
            __syncthreads();
            const int C = tmisc[0];
            if (IN(pb + 5)) {
                FILL_GROUPED(C * 4, 2);
                const int nu = tmisc[1];
_Pragma("nounroll")
                for (int i = 0; i < nu; ++i) { const int pm_ = utab[2 * i], e = utab[2 * i + 1] >> 2, r0 = (pm_ - pstart[e]) * 256; const int n = (int)__hip_atomic_load(cnt + e * 16, RLX_AGENT);
                    for (int r = tid; r < 256; r += 512) { const int rk = (r0 + r < n) ? r0 + r : r0; rowtab[i * 256 + r] = (unsigned)LIST[e * M + rk] * (unsigned)(DM * 2); } }
                __syncthreads();
                pg8::TabOrder S{nu, utab, rowtab};
                pg8::Gemm g{XB, WGU_T + (size_t)l * NE * 1024 * DM, DM};
                pg8::EpiSwiGLU E{HID};
                pg8::gemm_phase<pg8::EpiSwiGLU, pg8::TabOrder, true>(lds, g, S, E);
                if (BOTH(pb + 5)) GRID_BAR();
            }
            if (IN(pb + 6)) {
                FILL_GROUPED(C * 8, 3);
                pg8::TabOrder S{tmisc[1], utab, rowtab};
                pg8::Gemm g{HID, WD_T + (size_t)l * NE * DM * DE, DE};
                pg8::EpiDown E{YS};
                pg8::gemm_phase<pg8::EpiDown, pg8::TabOrder, false>(lds, g, S, E);
                if (BOTH(pb + 6)) GRID_BAR();
            }
        }

        if (IN(pb + 7)) {
            PHASE_LOCALS
            LAS float* gl = (LAS float*)lds; LAS float* bl = (LAS float*)(lds + 8192); LAS int* pstart = (LAS int*)(lds + T_PSTART);
            for (int i = tid; i < DM; i += 512) { gl[i] = args.in[I_LN2G][l * DM + i]; bl[i] = args.in[I_LN2B][l * DM + i]; }
            if (tid == 0) { int C = 0;
_Pragma("nounroll")
                for (int e = 0; e < NE; ++e) { const int n = (int)__hip_atomic_load(cnt + e * 16, RLX_AGENT); pstart[e] = C * 256; C += (n + 255) >> 8; } }
            __syncthreads();
            const int gw = vcu * 8 + wave, NGW = G * 8;
            for (int row = gw; row < M; row += NGW) {
                const u32x4 ta = *(const GAS u32x4*)(TOK + (size_t)row * 8); const u32x2 tb = *(const GAS u32x2*)(TOK + (size_t)row * 8 + 4);
                const int s0 = pstart[ta.x] + (int)ta.y, s1 = pstart[ta.z] + (int)ta.w; const float w0 = __uint_as_float(tb.x), w1 = __uint_as_float(tb.y);
                const GAS f32x4* xr = (const GAS f32x4*)(QBUF + (size_t)row * DM) + lane;
                const GAS u32x2* y0 = (const GAS u32x2*)(YS + (size_t)s0 * DM) + lane; const GAS u32x2* y1 = (const GAS u32x2*)(YS + (size_t)s1 * DM) + lane;
                f32x4 v[8]; float s = 0.f;
#pragma unroll
                for (int j = 0; j < 8; ++j) { const f32x4 xx = xr[64 * j]; const u32x2 a = y0[64 * j], b = y1[64 * j];
                    f32x4 t; t[0] = xx[0] * ALPHA + (w0 * bf_lo(a.x) + w1 * bf_lo(b.x)); t[1] = xx[1] * ALPHA + (w0 * bf_hi(a.x) + w1 * bf_hi(b.x));
                    t[2] = xx[2] * ALPHA + (w0 * bf_lo(a.y) + w1 * bf_lo(b.y)); t[3] = xx[3] * ALPHA + (w0 * bf_hi(a.y) + w1 * bf_hi(b.y));
                    v[j] = t; s += (t[0] + t[1]) + (t[2] + t[3]); }
                const float mean = wave_sum(s) * (1.f / DM); float s2 = 0.f;
#pragma unroll
                for (int j = 0; j < 8; ++j) { v[j] = v[j] - mean; s2 += (v[j][0] * v[j][0] + v[j][1] * v[j][1]) + (v[j][2] * v[j][2] + v[j][3] * v[j][3]); }
                const float rstd = 1.f / sqrtf(wave_sum(s2) * (1.f / DM) + LN_EPS);
                GAS f32x4* po = (GAS f32x4*)(Pout + (size_t)row * DM) + lane; GAS u32x2* o8 = (GAS u32x2*)(XB + (size_t)row * DM) + lane;
#pragma unroll
                for (int j = 0; j < 8; ++j) { const f32x4 gg = *(const LAS f32x4*)(gl + 256 * j + 4 * lane), bb = *(const LAS f32x4*)(bl + 256 * j + 4 * lane);
                    const f32x4 y = v[j] * rstd * gg + bb; po[64 * j] = y;
                    u32x2 w; w.x = cvt_pk_bf16(y[0], y[1]); w.y = cvt_pk_bf16(y[2], y[3]); o8[64 * j] = w; }
            }
            if (BOTH(pb + 7)) GRID_BAR();
        }
    }
#undef IN
#undef BOTH
#undef GRID_BAR
}

extern "C" void kernel_launch(void* const* d_in, const int* in_sizes, int n_in, void* d_out, int out_size, void* d_ws, size_t ws_size, hipStream_t stream) {
    static int grid = 0;
    if (grid == 0) {
        if (n_in != 17 || in_sizes[0] != M * DM || out_size != M * DM || ws_size < WS_END) { fprintf(stderr, "kernel_launch: unexpected shapes (n_in %d in0 %d out %d ws %zu, need ws >= %zu); nothing launched\n", n_in, n_in > 0 ? in_sizes[0] : -1, out_size, ws_size, (size_t)WS_END); grid = -1; return; }
        int dev = 0, cus = 0, per_cu = 0;
        if (hipGetDevice(&dev) != hipSuccess || hipDeviceGetAttribute(&cus, hipDeviceAttributeMultiprocessorCount, dev) != hipSuccess) { grid = -1; return; }
        if (hipFuncSetAttribute((const void*)trunk_fwd, hipFuncAttributeMaxDynamicSharedMemorySize, LDS_BYTES) != hipSuccess) { fprintf(stderr, "kernel_launch: hipFuncSetAttribute failed\n"); grid = -1; return; }
        if (hipOccupancyMaxActiveBlocksPerMultiprocessor(&per_cu, (const void*)trunk_fwd, 512, LDS_BYTES) != hipSuccess || per_cu < 1) fprintf(stderr, "kernel_launch: occupancy query reports %d\n", per_cu);
        (void)hipGetLastError();
        grid = cus;
    }
    if (grid < 0) return;
    if (hipMemsetAsync((char*)d_ws + WS_CTL, 0, CTL_ZERO_BYTES, stream) != hipSuccess) return;
    Args a{};
    for (int i = 0; i < 17; ++i) a.in[i] = (const float*)d_in[i];
    a.out = (float*)d_out; a.ws = (unsigned char*)d_ws;
#if MK_PER_PHASE
    for (int ph = 0; ph < NPHASE; ++ph) { a.ph_lo = ph; a.ph_hi = ph + 1; hipLaunchKernelGGL(trunk_fwd, dim3(grid), dim3(512), LDS_BYTES, stream, a); }
#else
    a.ph_lo = 0; a.ph_hi = NPHASE; hipLaunchKernelGGL(trunk_fwd, dim3(grid), dim3(512), LDS_BYTES, stream, a);
#endif
}
```

```cpp
#include <hip/hip_runtime.h>
#include <hip/hip_bf16.h>
#include <cstdio>
#include <cstdint>

#ifndef MK_PER_PHASE
#define MK_PER_PHASE 0
#endif

constexpr int BATCH = 2, SEQ = 8192, DM = 2048, DEPTH = 4, HD = 128, M = BATCH * SEQ;
constexpr int FOXH = 8, DIFH = 4, NPROJ = 6144, INW = 6152;
constexpr int NE = 32, DE = 512, NSLOT = 40960;
constexpr float LN_EPS = 1e-5f, RMS_EPS = 1e-5f;
constexpr float FOX_PRUNE_T = 30.f;
constexpr float ALPHA = 1.681792830507429f;
constexpr int NPHASE = 1 + 8 * DEPTH;

#define GAS __attribute__((address_space(1)))
#define LAS __attribute__((address_space(3)))
typedef unsigned short bf16_t;
typedef short bf16x8 __attribute__((ext_vector_type(8)));
typedef short s16x4 __attribute__((ext_vector_type(4)));
typedef float f32x4 __attribute__((ext_vector_type(4)));
typedef float f32x2 __attribute__((ext_vector_type(2)));
typedef float f32x16 __attribute__((ext_vector_type(16)));
typedef unsigned u32x4 __attribute__((ext_vector_type(4)));
typedef unsigned u32x2 __attribute__((ext_vector_type(2)));
typedef GAS unsigned gu32;
#define RLX_AGENT __ATOMIC_RELAXED, __HIP_MEMORY_SCOPE_AGENT

constexpr size_t MiB = 1u << 20;
constexpr size_t WS_CTL = 0, CTL_ZERO_BYTES = 65536;
constexpr size_t WS_COS = 1 * MiB, WS_SIN = 1 * MiB + 512 * 1024;
constexpr size_t WS_WF = 2 * MiB, WS_WR = 2 * MiB + 256 * 1024;
constexpr size_t WS_LOGF = 3 * MiB, WS_TOK = 3 * MiB + 512 * 1024;
constexpr size_t WS_LIST = 4 * MiB;
constexpr size_t WS_WIN = 8 * MiB, WS_WO = 104 * MiB, WS_WGU = 136 * MiB, WS_WD = 648 * MiB;
constexpr size_t WS_P = 904 * MiB, WS_Q = 1032 * MiB, WS_XB = 1160 * MiB, WS_PROJ = 1224 * MiB, WS_MRG = 1416 * MiB, WS_OD = 1480 * MiB;
constexpr size_t WS_HID = 1608 * MiB, WS_YS = 1648 * MiB, WS_END = 1808 * MiB;
constexpr int CW_TMO = 0, CW_CNT = 1024, CW_QHEAD = 3072, CW_BAR = 4096, CW_NMAX = 8192;

constexpr int RING_BYTES = 131072;
constexpr int TAB_OFF = RING_BYTES;
constexpr int T_CHUNK_E = TAB_OFF, T_PSTART = TAB_OFF + 1024, T_HIST = TAB_OFF + 1280, T_BASE = TAB_OFF + 1536, T_MISC = TAB_OFF + 1792, T_UTAB = TAB_OFF + 1856, T_ROWTAB = TAB_OFF + 2048;
constexpr int MISC_OFF = 147456 - 128;
constexpr int LDS_BYTES = 147456;

__device__ __forceinline__ unsigned cvt_pk_bf16(float lo, float hi) { unsigned r; asm volatile("v_cvt_pk_bf16_f32 %0, %1, %2" : "=v"(r) : "v"(lo), "v"(hi)); return r; }
__device__ __forceinline__ unsigned f2bf(float f) { unsigned u = __builtin_bit_cast(unsigned, f); return (u + 0x7fffu + ((u >> 16) & 1u)) >> 16; }
__device__ __forceinline__ unsigned pk2(float lo, float hi) { return f2bf(lo) | (f2bf(hi) << 16); }
__device__ __forceinline__ float bf_lo(unsigned w) { return __builtin_bit_cast(float, w << 16); }
__device__ __forceinline__ float bf_hi(unsigned w) { return __builtin_bit_cast(float, w & 0xffff0000u); }
__device__ __forceinline__ float wave_sum(float v) {
#pragma unroll
    for (int o = 1; o < 64; o <<= 1) v += __shfl_xor(v, o);
    return v;
}
__device__ __forceinline__ unsigned char* opaque_ptr(unsigned char* p) { asm volatile("" : "+s"(p)); return p; }
__device__ __forceinline__ int opaque_tid() { int t = threadIdx.x; asm volatile("" : "+v"(t)); return t; }
#define LDS_WAIT() asm volatile("s_waitcnt lgkmcnt(0)" ::: "memory")
#define VM_WAIT() asm volatile("s_waitcnt vmcnt(0)" ::: "memory")

namespace pg8 {
constexpr int BM = 256, BK = 64, HALF = 128, HTB = HALF * BK * 2, STAGE_BYTES = 8 * HTB, NXCD = 8, WGM = 8;
__host__ __device__ __forceinline__ int lds_byte(int r, int c) { const int st = (r >> 4) * 2 + (c >> 5), rr = r & 15, cc = c & 31, ob = rr * 64 + cc * 2; return st * 1024 + (ob ^ (((ob >> 9) & 1) << 5)); }
__host__ __device__ __forceinline__ void stage_rc(int b, int& R, int& C) { const int st = b / 1024, sb = b % 1024, swz = sb ^ (((sb >> 9) & 1) << 5); R = (st >> 1) * 16 + swz / 64; C = (st & 1) * 32 + (swz % 64) / 2; }
__host__ __device__ __forceinline__ int perm32(int rho) { const int n = rho >> 4, i = rho & 15; return 8 * (i >> 2) + 4 * n + (i & 3); }

struct Unit { int pm, pn; };
struct Gemm { const bf16_t* A; const bf16_t* Bt; int K; };

struct StaticOrder {
    int nM, nN, nwg, G, c;
    __device__ void init(int Mr, int N, int G_, int c_) { nM = Mr / BM; nN = N / BM; nwg = nM * nN; G = G_; c = c_; }
    __device__ bool next(int i, Unit& u) const {
        const long L = (long)i * G + c; if (L >= nwg) return false;
        int wgid = (int)L; { const int q = nwg / NXCD, r = nwg % NXCD, xcd = wgid % NXCD, off = wgid / NXCD; wgid = (xcd < r ? xcd * (q + 1) : r * (q + 1) + (xcd - r) * q) + off; }
        const int nig = WGM * nN, gid = wgid / nig, fm = gid * WGM, gsz = (nM - fm) < WGM ? (nM - fm) : WGM;
        u.pm = fm + ((wgid % nig) % gsz); u.pn = (wgid % nig) / gsz; return true;
    }
};
struct TabOrder {
    int n; const LAS int* utab; const LAS unsigned* rowtab;
    __device__ __forceinline__ bool next(int i, Unit& u) const { if (i >= n) return false; u.pm = __builtin_amdgcn_readfirstlane(utab[2 * i]); u.pn = __builtin_amdgcn_readfirstlane(utab[2 * i + 1]); return true; }
    __device__ __forceinline__ const LAS unsigned* rows(int i) const { return rowtab + 256 * i; }
};
__device__ __forceinline__ bool grouped_unit(int U, int x, int j, int G8, int ntn_shift, const LAS int* chunk_e, int i, Unit& u) {
    const int q = U / 8, r = U % 8; const int lo = x * q + (x < r ? x : r), sz = q + (x < r ? 1 : 0);
    const int idx = j + i * G8; if (idx >= sz) return false;
    const int L = lo + idx, chunk = L >> ntn_shift, cn = L & ((1 << ntn_shift) - 1);
    u.pm = chunk; u.pn = (chunk_e[chunk] << ntn_shift) + cn; return true;
}

template <class Epi, class Sched, bool GATHER>
__device__ __forceinline__ void gemm_phase(LAS unsigned char* lds, const Gemm g, const Sched& S, const Epi& E) {
    const int tid = opaque_tid(), wid = __builtin_amdgcn_readfirstlane(tid >> 6), lane = tid & 63, wr = wid >> 2, wc = wid & 3, fr = lane & 15, fq = lane >> 4;
    const int K = g.K, nt = K / BK;
    unsigned voffA[2], voffB[2]; int RA[2];
#pragma unroll
    for (int i = 0; i < 2; ++i) { int R, C; stage_rc(tid * 16 + i * 8192, R, C); const int Rb = Epi::PERM ? ((R & ~31) + perm32(R & 31)) : R;
        voffA[i] = GATHER ? (unsigned)(C * 2) : (unsigned)(R * K + C) * 2u; voffB[i] = (unsigned)(Rb * K + C) * 2u; RA[i] = R; }
    const size_t kstep = (size_t)(BK * 2);
    const size_t hstep = (size_t)HALF * K * 2;
    const size_t tstep = 2 * hstep;
    const unsigned ldsw = (unsigned)wid * 1024u;
    const int aoff = lds_byte(wr * 64 + fr, fq * 8), boff = lds_byte(wc * 32 + fr, fq * 8);
#define PG8_SA(b, h) (((b) * 2 + (h)) * HTB)
#define PG8_SB(b, h) ((4 + (b) * 2 + (h)) * HTB)
#define PG8_STAGE2(bufoff, gbase, v0, v1) do { \
        __builtin_amdgcn_global_load_lds((const unsigned*)((const char*)(gbase) + (v0)), (LAS unsigned*)(lds + (bufoff) + ldsw), 16, 0, 0); \
        __builtin_amdgcn_global_load_lds((const unsigned*)((const char*)(gbase) + (v1)), (LAS unsigned*)(lds + (bufoff) + ldsw + 8192), 16, 0, 0); } while (0)
#define PG8_STAGEB(bufoff, gbase) PG8_STAGE2(bufoff, gbase, voffB[0], voffB[1])
#define PG8_STAGEA(bufoff, gbase, h, NX) do { if constexpr (GATHER) { PG8_STAGE2(bufoff, gbase, va[h][0], va[h][1]); } \
        else { PG8_STAGE2(bufoff, (gbase) + (h) * hstep, voffA[0], voffA[1]); } } while (0)
#define PG8_LDA(dst, b, h) do { _Pragma("unroll") for (int m = 0; m < 4; ++m) _Pragma("unroll") for (int k = 0; k < 2; ++k) dst[m][k] = *(const LAS bf16x8*)(lds + PG8_SA(b, h) + aoff + m * 2048 + k * 1024); } while (0)
#define PG8_LDB(dst, b, h) do { _Pragma("unroll") for (int n = 0; n < 2; ++n) _Pragma("unroll") for (int k = 0; k < 2; ++k) dst[n][k] = *(const LAS bf16x8*)(lds + PG8_SB(b, h) + boff + n * 2048 + k * 1024); } while (0)
#define PG8_MMA(ai, bj, At, Bt) do { __builtin_amdgcn_s_setprio(1); _Pragma("unroll") for (int m = 0; m < 4; ++m) _Pragma("unroll") for (int n = 0; n < 2; ++n) _Pragma("unroll") for (int k = 0; k < 2; ++k) \
        acc[ai][bj][m][n] = __builtin_amdgcn_mfma_f32_16x16x32_bf16(Bt[n][k], At[m][k], acc[ai][bj][m][n], 0, 0, 0); __builtin_amdgcn_s_setprio(0); } while (0)
#define PG8_WAIT_V(n) asm volatile("s_waitcnt vmcnt(" #n ")" ::: "memory")
#define PG8_WAIT_L(n) asm volatile("s_waitcnt lgkmcnt(" #n ")" ::: "memory")
#define PG8_BAR __builtin_amdgcn_s_barrier()
#define PG8_SCHED __builtin_amdgcn_sched_barrier(0)
    Unit cur, nxt; int ui = 0;
    if (!S.next(0, cur)) return;
    f32x4 acc[2][2][4][2];
#pragma unroll
    for (int a = 0; a < 2; ++a)
#pragma unroll
        for (int b = 0; b < 2; ++b)
#pragma unroll
            for (int m = 0; m < 4; ++m)
#pragma unroll
                for (int n = 0; n < 2; ++n) acc[a][b][m][n] = (f32x4){0.f, 0.f, 0.f, 0.f};
    bf16x8 At[4][2], B0[2][2], B1[2][2];
    unsigned va[2][2];
    if constexpr (GATHER) { const LAS unsigned* rt = S.rows(0);
#pragma unroll
        for (int h = 0; h < 2; ++h)
#pragma unroll
            for (int i = 0; i < 2; ++i) va[h][i] = rt[h * HALF + RA[i]] + voffA[i]; }
    else { va[0][0] = va[0][1] = va[1][0] = va[1][1] = 0u; }
    const char* cA = GATHER ? (const char*)g.A : (const char*)g.A + (size_t)cur.pm * tstep; const char* cB = (const char*)g.Bt + (size_t)cur.pn * tstep;
    PG8_STAGEB(PG8_SB(0, 0), cB); PG8_STAGEB(PG8_SB(0, 1), cB + hstep); PG8_STAGEA(PG8_SA(0, 0), cA, 0, false); PG8_STAGEA(PG8_SA(0, 1), cA, 1, false);
    if (wr == 1) PG8_BAR;
    PG8_WAIT_V(2); PG8_BAR;
    PG8_STAGEB(PG8_SB(1, 0), cB + kstep); PG8_STAGEA(PG8_SA(1, 0), cA + kstep, 0, false); PG8_STAGEB(PG8_SB(1, 1), cB + hstep + kstep);
    PG8_WAIT_V(6); PG8_BAR;
    for (;;) {
        const bool has_next = S.next(ui + 1, nxt);
        const char* nA = GATHER ? cA : (has_next ? (const char*)g.A + (size_t)nxt.pm * tstep : cA); const char* nB = has_next ? (const char*)g.Bt + (size_t)nxt.pn * tstep : cB;
#pragma nounroll
        for (int t = 0; t < nt; t += 2) {
            const bool last = (t == nt - 2);
            const char* a1 = cA + (size_t)(t + 1) * kstep;
            const char* a2 = last ? nA : cA + (size_t)(t + 2) * kstep; const char* b2 = last ? nB : cB + (size_t)(t + 2) * kstep;
            const char* a3 = a2 + kstep; const char* b3 = b2 + kstep;
            PG8_LDB(B0, 0, 0); PG8_LDB(B1, 0, 1); PG8_SCHED; PG8_LDA(At, 0, 0); PG8_STAGEA(PG8_SA(1, 1), a1, 1, false);
            if constexpr (GATHER) { if (last && has_next) { const LAS unsigned* rt = S.rows(ui + 1);
#pragma unroll
                for (int h = 0; h < 2; ++h)
#pragma unroll
                    for (int i = 0; i < 2; ++i) va[h][i] = rt[h * HALF + RA[i]] + voffA[i]; } }
            PG8_WAIT_V(8); PG8_WAIT_L(0); PG8_BAR; PG8_MMA(0, 0, At, B0); PG8_MMA(0, 1, At, B1); PG8_BAR; PG8_SCHED;
            PG8_LDA(At, 0, 1); PG8_STAGEB(PG8_SB(0, 0), b2); PG8_STAGEB(PG8_SB(0, 1), b2 + hstep); PG8_STAGEA(PG8_SA(0, 0), a2, 0, last);
            PG8_WAIT_V(8); PG8_WAIT_L(0); PG8_BAR; PG8_MMA(1, 0, At, B0); PG8_MMA(1, 1, At, B1); PG8_BAR; PG8_SCHED;
            PG8_LDB(B0, 1, 0); PG8_LDB(B1, 1, 1); PG8_SCHED; PG8_LDA(At, 1, 0); PG8_STAGEA(PG8_SA(0, 1), a2, 1, last);
            PG8_WAIT_V(8); PG8_WAIT_L(0); PG8_BAR; PG8_MMA(0, 0, At, B0); PG8_MMA(0, 1, At, B1); PG8_BAR; PG8_SCHED;
            PG8_LDA(At, 1, 1); PG8_STAGEB(PG8_SB(1, 0), b3); PG8_STAGEB(PG8_SB(1, 1), b3 + hstep); PG8_STAGEA(PG8_SA(1, 0), a3, 0, last);
            PG8_WAIT_V(8); PG8_WAIT_L(0); PG8_BAR; PG8_MMA(1, 0, At, B0); PG8_MMA(1, 1, At, B1); PG8_BAR; PG8_SCHED;
        }
        if (wr == 0) PG8_BAR;
        E(acc, cur, wr, wc, fr, fq);
        if (!has_next) break;
#pragma unroll
        for (int a = 0; a < 2; ++a)
#pragma unroll
            for (int b = 0; b < 2; ++b)
#pragma unroll
                for (int m = 0; m < 4; ++m)
#pragma unroll
                    for (int n = 0; n < 2; ++n) acc[a][b][m][n] = (f32x4){0.f, 0.f, 0.f, 0.f};
        cur = nxt; cA = nA; cB = nB; ++ui;
        if (wr == 1) PG8_BAR;
    }
    PG8_WAIT_V(0);
    PG8_BAR;
#undef PG8_SA
#undef PG8_SB
#undef PG8_STAGE2
#undef PG8_STAGEB
#undef PG8_STAGEA
#undef PG8_LDA
#undef PG8_LDB
#undef PG8_MMA
#undef PG8_WAIT_V
#undef PG8_WAIT_L
#undef PG8_BAR
#undef PG8_SCHED
}

struct EpiInProj {
    static constexpr bool PERM = true;
    unsigned char* wsb; int layer;
    __device__ __forceinline__ void operator()(const f32x4 (&acc)[2][2][4][2], const Unit& u, int wr, int wc, int fr, int fq) const {
        const float* cosT = (const float*)(wsb + WS_COS); const float* sinT = (const float*)(wsb + WS_SIN);
        const int tsel = u.pn >> 2; bf16_t* base = (bf16_t*)(wsb + WS_PROJ) + (size_t)tsel * ((size_t)M * 1024);
        const int row0 = u.pm * BM + wr * 64 + fr, col0 = (u.pn & 3) * BM + wc * 32 + 8 * fq;
        const bool rope = (tsel == 3 || tsel == 4) && (wc == 0);
        const float sgn = (fq < 2) ? -1.f : 1.f; const int i0 = 8 * (fq & 1);
        if (tsel < 2) {
            float mx0 = 0.f, mx1 = 0.f;
#pragma unroll
            for (int ai = 0; ai < 2; ++ai)
#pragma unroll
                for (int m = 0; m < 4; ++m) {
#pragma unroll
                    for (int bj = 0; bj < 2; ++bj) { const f32x4 v0 = acc[ai][bj][m][0], v1 = acc[ai][bj][m][1];
                        float ss = (v0[0] * v0[0] + v0[1] * v0[1]) + (v0[2] * v0[2] + v0[3] * v0[3]) + (v1[0] * v1[0] + v1[1] * v1[1]) + (v1[2] * v1[2] + v1[3] * v1[3]);
                        ss += __shfl_xor(ss, 16); ss += __shfl_xor(ss, 32);
                        if (bj == 0) mx0 = fmaxf(mx0, ss); else mx1 = fmaxf(mx1, ss); } }
#pragma unroll
            for (int o = 1; o < 16; o <<= 1) { mx0 = fmaxf(mx0, __shfl_xor(mx0, o)); mx1 = fmaxf(mx1, __shfl_xor(mx1, o)); }
            if (fr == 0 && fq == 0) { unsigned* nm = (unsigned*)(wsb + WS_CTL) + CW_NMAX + layer * 256; const int bh0 = (u.pm >> 5) * 8 + 2 * (u.pn & 3);
                __hip_atomic_fetch_max(nm + ((bh0 + 0) * 4 + wc) * 2 + tsel, __float_as_uint(mx0 * 1.02f), RLX_AGENT);
                __hip_atomic_fetch_max(nm + ((bh0 + 1) * 4 + wc) * 2 + tsel, __float_as_uint(mx1 * 1.02f), RLX_AGENT); }
        }
#pragma unroll
        for (int ai = 0; ai < 2; ++ai)
#pragma unroll
            for (int m = 0; m < 4; ++m) { const int row = row0 + ai * HALF + m * 16; bf16_t* rowp = base + (size_t)row * 1024 + col0;
                f32x4 c0 = (f32x4){1.f, 1.f, 1.f, 1.f}, c1 = c0, s0 = (f32x4){0.f, 0.f, 0.f, 0.f}, s1 = s0;
                if (rope) { const int pos = row & (SEQ - 1); c0 = *(const f32x4*)(cosT + pos * 16 + i0); c1 = *(const f32x4*)(cosT + pos * 16 + i0 + 4); s0 = *(const f32x4*)(sinT + pos * 16 + i0); s1 = *(const f32x4*)(sinT + pos * 16 + i0 + 4); }
#pragma unroll
                for (int bj = 0; bj < 2; ++bj) { f32x4 v0 = acc[ai][bj][m][0], v1 = acc[ai][bj][m][1];
                    if (rope) { f32x4 p0, p1;
#pragma unroll
                        for (int j = 0; j < 4; ++j) { p0[j] = __shfl_xor(v0[j], 32); p1[j] = __shfl_xor(v1[j], 32); }
                        v0 = v0 * c0 + (p0 * s0) * sgn; v1 = v1 * c1 + (p1 * s1) * sgn; }
                    u32x4 w; w.x = cvt_pk_bf16(v0[0], v0[1]); w.y = cvt_pk_bf16(v0[2], v0[3]); w.z = cvt_pk_bf16(v1[0], v1[1]); w.w = cvt_pk_bf16(v1[2], v1[3]);
                    *(u32x4*)(rowp + bj * HALF) = w; } }
    }
};
struct EpiRes {
    static constexpr bool PERM = false;
    const float* P; float* Qo; float alpha;
    __device__ __forceinline__ void operator()(const f32x4 (&acc)[2][2][4][2], const Unit& u, int wr, int wc, int fr, int fq) const {
        const int row0 = u.pm * BM + wr * 64 + fr, col0 = u.pn * BM + wc * 32 + 4 * fq;
#pragma unroll
        for (int ai = 0; ai < 2; ++ai)
#pragma unroll
            for (int m = 0; m < 4; ++m) { const size_t off = (size_t)(row0 + ai * HALF + m * 16) * DM + col0;
#pragma unroll
                for (int bj = 0; bj < 2; ++bj)
#pragma unroll
                    for (int n = 0; n < 2; ++n) { const f32x4 x = *(const f32x4*)(P + off + bj * HALF + n * 16); *(f32x4*)(Qo + off + bj * HALF + n * 16) = x * alpha + acc[ai][bj][m][n]; } }
    }
};
struct EpiSwiGLU {
    static constexpr bool PERM = true;
    bf16_t* H;
    __device__ __forceinline__ void operator()(const f32x4 (&acc)[2][2][4][2], const Unit& u, int wr, int wc, int fr, int fq) const {
        const int row0 = u.pm * BM + wr * 64 + fr, col0 = (u.pn & 3) * HALF + wc * 32 + 8 * fq;
#pragma unroll
        for (int ai = 0; ai < 2; ++ai)
#pragma unroll
            for (int m = 0; m < 4; ++m) { bf16_t* rowp = H + (size_t)(row0 + ai * HALF + m * 16) * DE + col0; float h[8];
#pragma unroll
                for (int n = 0; n < 2; ++n)
#pragma unroll
                    for (int j = 0; j < 4; ++j) { const float gg = acc[ai][0][m][n][j], uu = acc[ai][1][m][n][j];
                        h[n * 4 + j] = gg * uu * __builtin_amdgcn_rcpf(1.f + __builtin_amdgcn_exp2f(-1.4426950408889634f * gg)); }
                u32x4 w; w.x = cvt_pk_bf16(h[0], h[1]); w.y = cvt_pk_bf16(h[2], h[3]); w.z = cvt_pk_bf16(h[4], h[5]); w.w = cvt_pk_bf16(h[6], h[7]);
                *(u32x4*)rowp = w; }
    }
};
struct EpiDown {
    static constexpr bool PERM = true;
    bf16_t* Y;
    __device__ __forceinline__ void operator()(const f32x4 (&acc)[2][2][4][2], const Unit& u, int wr, int wc, int fr, int fq) const {
        const int row0 = u.pm * BM + wr * 64 + fr, col0 = (u.pn & 7) * BM + wc * 32 + 8 * fq;
#pragma unroll
        for (int ai = 0; ai < 2; ++ai)
#pragma unroll
            for (int m = 0; m < 4; ++m) { bf16_t* rowp = Y + (size_t)(row0 + ai * HALF + m * 16) * DM + col0;
#pragma unroll
                for (int bj = 0; bj < 2; ++bj) { const f32x4 v0 = acc[ai][bj][m][0], v1 = acc[ai][bj][m][1];
                    u32x4 w; w.x = cvt_pk_bf16(v0[0], v0[1]); w.y = cvt_pk_bf16(v0[2], v0[3]); w.z = cvt_pk_bf16(v1[0], v1[1]); w.w = cvt_pk_bf16(v1[2], v1[3]);
                    *(u32x4*)(rowp + bj * HALF) = w; } }
    }
};
}

namespace att {
using bf16 = __hip_bfloat16;
constexpr int D = 128, KP = 1024, OP = 2048;
constexpr float SCALE = 0.08838834764831845f;
constexpr float THR = 8.f;
constexpr int NW = 8, QBLK = 32, KVBLK = 64, QB = NW * QBLK;
constexpr int SHM_V = KVBLK * D * 2, SHM_K = KVBLK * D * 2;
constexpr int LDS_ATT = 2 * SHM_V + 2 * SHM_K + NW * 64 * 4;
constexpr int LDS_C = LDS_ATT, LDS_WT = LDS_C + SEQ * 4;
template <class A, class Bt> struct same_t { static constexpr bool v = false; };
template <class A> struct same_t<A, A> { static constexpr bool v = true; };
#define KSWZ(row, colB) ((row) * 256 + ((colB) ^ (((row) & 7) << 4)))
#define SBAR() __builtin_amdgcn_sched_barrier(0)
__device__ __forceinline__ int v_st(int k, int c) { const int kk = (k & ~0xC) | ((k & 4) << 1) | ((k & 8) >> 1); return ((kk >> 3) * 4 + (c >> 5)) * 512 + ((kk & 7) * 32 + (c & 31)) * 2; }
__device__ __forceinline__ int v_rd_base(int lane) { return ((lane & 3) << 3) | (((lane >> 2) & 3) << 6) | (((lane >> 4) & 1) << 5) | (((lane >> 5) & 1) << 8); }
constexpr int v_rd_off(int d0, int ks, int half) { return d0 * 512 + ks * 4096 + half * 2048; }
__device__ __forceinline__ int crow(int r, int hi) { return (r & 3) + 8 * (r >> 2) + 4 * hi; }
__device__ __forceinline__ unsigned cvtpk(float lo, float hi) { unsigned r; asm volatile("v_cvt_pk_bf16_f32 %0, %1, %2" : "=v"(r) : "v"(lo), "v"(hi)); return r; }
__device__ __forceinline__ bf16x8 load8(const bf16* p) { return *reinterpret_cast<const bf16x8*>(p); }
__device__ __forceinline__ void mask_tile(f32x16& p0, f32x16& p1, int dq, unsigned W) {
    const float NEG = -__builtin_inff();
#pragma unroll
    for (int r = 0; r < 16; ++r) {
        const int c = (r & 3) + 8 * (r >> 2);
        if ((unsigned)(dq - c) >= W) p0[r] = NEG;
        if ((unsigned)(dq - c - 32) >= W) p1[r] = NEG;
    }
}
__device__ __forceinline__ void partialSM(f32x16& p0, f32x16& p1, float& m_reg, float& mn, float& alpha) {
    float pmax = p0[0]; for (int r = 1; r < 16; ++r) pmax = fmaxf(pmax, p0[r]); for (int r = 0; r < 16; ++r) pmax = fmaxf(pmax, p1[r]);
    { auto rr = __builtin_amdgcn_permlane32_swap(__float_as_uint(pmax), __float_as_uint(pmax), false, false);
      pmax = fmaxf(__uint_as_float(rr[0]), __uint_as_float(rr[1])); }
    constexpr float C2 = 1.4426950408889634f * SCALE;
    if (__builtin_expect(__all((pmax - m_reg) * SCALE <= THR), 1)) { mn = m_reg; alpha = 1.f; }
    else { mn = fmaxf(m_reg, pmax); alpha = __builtin_amdgcn_exp2f((m_reg - mn) * C2); m_reg = mn; }
    const float mnL = -mn * C2;
    for (int r = 0; r < 16; ++r) p0[r] = fmaf(p0[r], C2, mnL); for (int r = 0; r < 16; ++r) p1[r] = fmaf(p1[r], C2, mnL);
    for (int r = 0; r < 16; ++r) p0[r] = __builtin_amdgcn_exp2f(p0[r]);
}
__device__ __forceinline__ void finishSM(f32x16& p0, f32x16& p1, float alpha, float& l_reg, bf16x8& pa0, bf16x8& pa1, bf16x8& pa2, bf16x8& pa3) {
    for (int r = 0; r < 16; ++r) p1[r] = __builtin_amdgcn_exp2f(p1[r]);
    float ps = 0; for (int r = 0; r < 16; ++r) ps += p0[r]; for (int r = 0; r < 16; ++r) ps += p1[r];
    { auto rr = __builtin_amdgcn_permlane32_swap(__float_as_uint(ps), __float_as_uint(ps), false, false);
      ps = __uint_as_float(rr[0]) + __uint_as_float(rr[1]); }
    l_reg = l_reg * alpha + ps;
#define PK4(P, B_, OUT) do { unsigned a0 = cvtpk(P[B_+0], P[B_+1]), a1 = cvtpk(P[B_+2], P[B_+3]);                          \
        unsigned b0 = cvtpk(P[B_+4], P[B_+5]), b1 = cvtpk(P[B_+6], P[B_+7]);                                             \
        auto r0 = __builtin_amdgcn_permlane32_swap(a0, b0, false, false); auto r1 = __builtin_amdgcn_permlane32_swap(a1, b1, false, false); \
        u32x4 w = {r0[0], r1[0], r0[1], r1[1]}; OUT = *reinterpret_cast<bf16x8*>(&w); } while (0)
    PK4(p0, 0, pa0); PK4(p0, 8, pa1); PK4(p1, 0, pa2); PK4(p1, 8, pa3);
#undef PK4
}
template <int KB, bool FOX>
__device__ __forceinline__ void qkt(f32x16& p0, f32x16& p1, const char* K_lds, int r32, int hi, const bf16x8* qr, const float* cb, float cqs) {
    if constexpr (FOX) { const f32x4* cp = (const f32x4*)cb + hi;
#pragma unroll
        for (int g = 0; g < 4; ++g) { const f32x4 a = cp[2 * g], b = cp[8 + 2 * g];
#pragma unroll
            for (int j = 0; j < 4; ++j) { p0[4 * g + j] = cqs - a[j]; p1[4 * g + j] = cqs - b[j]; } } }
    else { p0 = f32x16{}; p1 = f32x16{}; }
    const char* kb[4];
#pragma unroll
    for (int dd = 0; dd < 4; ++dd) kb[dd] = K_lds + KB * SHM_K + KSWZ(r32, (dd * 16 + hi * 8) * 2);
#pragma unroll
    for (int d0 = 0; d0 < 8; ++d0) { const char* a = kb[d0 & 3] + (d0 >> 2) * 128;
        bf16x8 b0 = *reinterpret_cast<const bf16x8*>(a);
        bf16x8 b1 = *reinterpret_cast<const bf16x8*>(a + 32 * 256);
        p0 = __builtin_amdgcn_mfma_f32_32x32x16_bf16(b0, qr[d0], p0, 0, 0, 0);
        p1 = __builtin_amdgcn_mfma_f32_32x32x16_bf16(b1, qr[d0], p1, 0, 0, 0); }
}
template <int VB>
__device__ __forceinline__ void pv_tile(f32x16* o, int vb0, bf16x8 pa0, bf16x8 pa1, bf16x8 pa2, bf16x8 pa3) {
#define TRRD(dst, off) asm volatile("ds_read_b64_tr_b16 %0, %1 offset:%2" : "=&v"(dst) : "v"(vb0), "i"(off) : "memory")
#define PV_D0(d0) do { s16x4 l0, l1, l2, l3, h0, h1, h2, h3; constexpr int b_ = VB * SHM_V + v_rd_off(d0, 0, 0); \
        TRRD(l0, b_); TRRD(h0, b_ + 2048); TRRD(l1, b_ + 4096); TRRD(h1, b_ + 6144); TRRD(l2, b_ + 8192); TRRD(h2, b_ + 10240); TRRD(l3, b_ + 12288); TRRD(h3, b_ + 14336); \
        asm volatile("s_waitcnt lgkmcnt(0)" ::: "memory"); SBAR();   \
        o[d0] = __builtin_amdgcn_mfma_f32_32x32x16_bf16(pa0, (bf16x8){l0[0], l0[1], l0[2], l0[3], h0[0], h0[1], h0[2], h0[3]}, o[d0], 0, 0, 0);   \
        o[d0] = __builtin_amdgcn_mfma_f32_32x32x16_bf16(pa1, (bf16x8){l1[0], l1[1], l1[2], l1[3], h1[0], h1[1], h1[2], h1[3]}, o[d0], 0, 0, 0);   \
        o[d0] = __builtin_amdgcn_mfma_f32_32x32x16_bf16(pa2, (bf16x8){l2[0], l2[1], l2[2], l2[3], h2[0], h2[1], h2[2], h2[3]}, o[d0], 0, 0, 0);   \
        o[d0] = __builtin_amdgcn_mfma_f32_32x32x16_bf16(pa3, (bf16x8){l3[0], l3[1], l3[2], l3[3], h3[0], h3[1], h3[2], h3[3]}, o[d0], 0, 0, 0); } while (0)
    PV_D0(0); PV_D0(1); PV_D0(2); PV_D0(3);
#undef PV_D0
#undef TRRD
}
template <class TOut> struct BlockRef { const bf16* Q; const bf16* K; const bf16* V; TOut* O; int P0; int jlo; };
struct Seam { bf16x8 qr[8]; bf16x8 st_v0, st_v1, st_k0, st_k1; };
#define ROWB(p, k0, rr) ((const bf16*)((const char*)(p) + ((size_t)((k0) + (rr)) * KP * 2) + loff))
#define VMW() asm volatile("s_waitcnt vmcnt(0)" ::: "memory")
#define VMWN(n) asm volatile("s_waitcnt vmcnt(%0)" :: "i"(n) : "memory")
#define SLOAD_H(Kp, Vp, k0) do { S.st_v0 = load8(ROWB(Vp, k0, 0)); S.st_v1 = load8(ROWB(Vp, k0, 32));              \
                         S.st_k0 = load8(ROWB(Kp, k0, 0)); S.st_k1 = load8(ROWB(Kp, k0, 32)); } while (0)
#define SWRITE_HK(bf) do { *(bf16x8*)(K_lds + (bf) * SHM_K + kws) = S.st_k0; *(bf16x8*)(K_lds + (bf) * SHM_K + kws + 32 * 256) = S.st_k1; } while (0)
#define SWRITE_HV(bf) do { *(bf16x8*)(V_lds + (bf) * SHM_V + vst0) = S.st_v0; *(bf16x8*)(V_lds + (bf) * SHM_V + vst1) = S.st_v1; } while (0)
#define SWRITE_H(bf) do { SWRITE_HV(bf); SWRITE_HK(bf); } while (0)
template <class TOut>
__device__ __forceinline__ void prime(const BlockRef<TOut>& cur, char* lds, Seam& S) {
    const int tid = opaque_tid(), wid = __builtin_amdgcn_readfirstlane(tid >> 6), lane = tid & 63, r32 = lane & 31, hi = lane >> 5;
    const int sr = tid >> 4, sc = (tid & 15) * 8, kws = KSWZ(sr, sc * 2); char* K_lds = lds + 2 * SHM_V;
    const unsigned loff = (unsigned)(sr * KP + sc) * 2u, qoff = (unsigned)(r32 * KP + hi * 8) * 2u;
    { const char* qb_ = (const char*)cur.Q + (size_t)(wid * QBLK) * KP * 2;
#pragma unroll
    for (int d0 = 0; d0 < 8; ++d0) S.qr[d0] = load8((const bf16*)(qb_ + d0 * 32 + qoff)); }
    SLOAD_H(cur.K, cur.V, cur.jlo * KVBLK); VMW(); SWRITE_HK(0);
    __syncthreads();
}
template <class TOut, bool FOX>
__device__ __forceinline__ void block(const BlockRef<TOut>& cur, const BlockRef<TOut>& nxt, char* lds, Seam& S) {
    const int tid = opaque_tid(), wid = __builtin_amdgcn_readfirstlane(tid >> 6), lane = tid & 63, r32 = lane & 31, hi = lane >> 5;
    constexpr int W = SEQ;
    const int j_lo = cur.jlo; const int NT = (cur.P0 + QB - 1) / KVBLK + 1 - j_lo;
    const int qlo = cur.P0 + wid * QBLK, qm = qlo + r32 - 4 * hi;
    char* V_lds = lds; char* K_lds = lds + 2 * SHM_V;
    float* ws = (float*)(lds + 2 * SHM_V + 2 * SHM_K) + wid * 64; float* li_l = ws, * al_l = ws + 32;
    const float* c_l = (const float*)(lds + LDS_C);
    float cqs = 0.f; if constexpr (FOX) cqs = c_l[qlo + r32];
    float m_reg = -1e30f, l_reg = 0; f32x16 o[4] = {};
    const int sr = tid >> 4, sc = (tid & 15) * 8, vst0 = v_st(sr, sc), vst1 = v_st(32 + sr, sc), kws = KSWZ(sr, sc * 2);
    const unsigned loff = (unsigned)(sr * KP + sc) * 2u, qoff = (unsigned)(r32 * KP + hi * 8) * 2u;
    const int vb0 = (int)(uintptr_t)V_lds + v_rd_base(lane);
    const bf16* Kh = cur.K; const bf16* Vh = cur.V;
#define RESC(a) do { if (__any((a) < 1.f)) { if (hi == 0) al_l[r32] = (a); asm volatile("s_waitcnt lgkmcnt(0)" ::: "memory");              \
                     for (int d_ = 0; d_ < 4; ++d_) for (int r = 0; r < 16; ++r) o[d_][r] *= al_l[crow(r, hi)]; } } while (0)
#define KBASE(t) ((j_lo + (t)) * KVBLK)
#define MASKT(P0_, P1_, t) do { const int kb_ = KBASE(t); if (kb_ + KVBLK - 1 > qlo) mask_tile(P0_, P1_, qm - kb_, (unsigned)W); } while (0)
    constexpr int NQL = 8;
#define SEAM_K0() do { VMWN(NQL); SWRITE_HK(0); SBAR(); } while (0)
    f32x16 pA0, pA1, pB0, pB1; float mnA, mnB, alA, alB; bf16x8 pa0, pa1, pa2, pa3;
    SWRITE_HV(0); SBAR();
    if (NT > 1) { SLOAD_H(Kh, Vh, KBASE(1)); }
    SBAR(); qkt<0, FOX>(pA0, pA1, K_lds, r32, hi, S.qr, c_l + KBASE(0), cqs);
    MASKT(pA0, pA1, 0); partialSM(pA0, pA1, m_reg, mnA, alA);
    if (NT > 1) { VMW(); SWRITE_H(1); }
    __syncthreads();
#define HALF_STEP(PX0, PX1, mnX, alX, PY0, PY1, alY, t, KB, VB, SB) do {                                                      \
        SBAR(); qkt<KB, FOX>(PX0, PX1, K_lds, r32, hi, S.qr, c_l + KBASE(t), cqs);                                          \
        finishSM(PY0, PY1, alY, l_reg, pa0, pa1, pa2, pa3); SBAR();                                                           \
        if ((t) + 1 < NT) { SLOAD_H(Kh, Vh, KBASE((t) + 1)); SBAR(); }                                                        \
        pv_tile<VB>(o, vb0, pa0, pa1, pa2, pa3); MASKT(PX0, PX1, (t)); partialSM(PX0, PX1, m_reg, mnX, alX);                \
        __syncthreads();                                                                                                      \
        if ((t) + 1 < NT) { VMW(); SWRITE_H(SB); }                                                                            \
        RESC(alX); __syncthreads(); } while (0)
    for (int t = 1; t + 1 < NT; t += 2) {
        HALF_STEP(pB0, pB1, mnB, alB, pA0, pA1, alA, t, 1, 0, 0);
        HALF_STEP(pA0, pA1, mnA, alA, pB0, pB1, alB, t + 1, 0, 1, 1);
    }
    const bool even = (NT & 1) == 0;
    if (even) { SBAR(); qkt<1, FOX>(pB0, pB1, K_lds, r32, hi, S.qr, c_l + KBASE(NT - 1), cqs); SBAR(); }
    SLOAD_H(nxt.K, nxt.V, nxt.jlo * KVBLK); SBAR();
    { const char* qb_ = (const char*)nxt.Q + (size_t)(wid * QBLK) * KP * 2;
#pragma unroll
    for (int d0 = 0; d0 < 8; ++d0) S.qr[d0] = load8((const bf16*)(qb_ + d0 * 32 + qoff)); }
    SBAR();
    finishSM(pA0, pA1, alA, l_reg, pa0, pa1, pa2, pa3); SBAR();
    pv_tile<0>(o, vb0, pa0, pa1, pa2, pa3);
    if (even) { MASKT(pB0, pB1, NT - 1); partialSM(pB0, pB1, m_reg, mnB, alB); __syncthreads(); RESC(alB);
        finishSM(pB0, pB1, alB, l_reg, pa0, pa1, pa2, pa3); SBAR(); pv_tile<1>(o, vb0, pa0, pa1, pa2, pa3); }
    SBAR(); SEAM_K0();
    if (hi == 0) li_l[r32] = l_reg; asm volatile("s_waitcnt lgkmcnt(0)" ::: "memory");
    float rli[16];
#pragma unroll
    for (int r = 0; r < 16; ++r) rli[r] = __builtin_amdgcn_rcpf(li_l[crow(r, hi)]);
    char* Ow = (char*)(cur.O + (size_t)(wid * QBLK) * OP);
    const unsigned ooff = (unsigned)(4 * hi * OP + r32) * (unsigned)sizeof(TOut);
#pragma unroll
    for (int r = 0; r < 16; ++r) { char* Or = Ow + (size_t)((r & 3) + 8 * (r >> 2)) * OP * sizeof(TOut);
#pragma unroll
        for (int d0 = 0; d0 < 4; ++d0) { const float v = o[d0][r] * rli[r];
            if constexpr (same_t<TOut, float>::v) { *(float*)(Or + d0 * 32 * 4 + ooff) = v; }
            else { const float vn = __shfl_xor(v, 1);
                   if ((r32 & 1) == 0) *(unsigned*)(Or + d0 * 32 * 2 + ooff) = cvtpk(v, vn); } } }
    __syncthreads();
#undef RESC
#undef KBASE
#undef MASKT
#undef SEAM_K0
#undef HALF_STEP
}
#undef ROWB
#undef VMW
#undef VMWN
#undef SLOAD_H
#undef SWRITE_HK
#undef SWRITE_HV
#undef SWRITE_H
#undef KSWZ
#undef SBAR
__device__ __forceinline__ void fox_load_c(const float* logf_bh, char* lds, int) {
    const int tid = opaque_tid(), lane = tid & 63, wid = tid >> 6;
    float* c_l = (float*)(lds + LDS_C); float* wt = (float*)(lds + LDS_WT);
    f32x4 v[4]; const f32x4* src = (const f32x4*)(logf_bh + 16 * tid);
#pragma unroll
    for (int i = 0; i < 4; ++i) v[i] = src[i];
    float run = 0.f;
#pragma unroll
    for (int i = 0; i < 4; ++i)
#pragma unroll
        for (int j = 0; j < 4; ++j) { run += v[i][j]; v[i][j] = run; }
    float inc = run;
#pragma unroll
    for (int o = 1; o < 64; o <<= 1) { const float t = __shfl_up(inc, o); if (lane >= o) inc += t; }
    if (lane == 63) wt[wid] = inc;
    __syncthreads();
    float base = inc - run;
    for (int w = 0; w < wid; ++w) base += wt[w];
    const float RS = 11.313708498984761f;
#pragma unroll
    for (int i = 0; i < 4; ++i) { f32x4 o;
#pragma unroll
        for (int j = 0; j < 4; ++j) o[j] = (v[i][j] + base) * RS;
        *(f32x4*)(c_l + 16 * tid + 4 * i) = o; }
}
__device__ __forceinline__ int fox_jlo(const char* lds, int P0, float thr) {
    const float* c_l = (const float*)(lds + LDS_C); const float cq = c_l[P0];
    int lo = 0, hi = P0 / KVBLK;
    while (lo < hi) { const int mid = (lo + hi) >> 1; const bool prune = (cq - c_l[mid * KVBLK + KVBLK - 1]) < -thr; if (prune) lo = mid + 1; else hi = mid; }
    return __builtin_amdgcn_readfirstlane(lo);
}
}

#define XB_TMO      128
#define XB_XCNT(j)  (256  + 64 * (j))
#define XB_XSUB(j)  (1280 + 64 * (j))
#define XB_XGEN(j)  (2304 + 64 * (j))
#define XB_TOP      3328
#define XB_TOPGEN   3392
#define XCD_BAR_WORDS 3456
#define XB_SPIN_CAP (1u << 18)
__device__ __forceinline__ unsigned xb_ld(unsigned* p)              { return __hip_atomic_load(p, __ATOMIC_RELAXED, __HIP_MEMORY_SCOPE_AGENT); }
__device__ __forceinline__ unsigned xb_add(unsigned* p, unsigned v) { return __hip_atomic_fetch_add(p, v, __ATOMIC_RELAXED, __HIP_MEMORY_SCOPE_AGENT); }
__device__ __forceinline__ unsigned xb_xcc_id() { return (unsigned)__builtin_amdgcn_s_getreg((3 << 11) | 20) & 0xFu; }
#define XB_SPIN(cond, bar) do { unsigned _sp = 0; while (cond) { __builtin_amdgcn_s_sleep(1); \
    if ((++_sp & 255u) == 0u) { if (xb_ld(&(bar)[XB_TMO])) break; if (_sp > XB_SPIN_CAP) { atomicAdd(&(bar)[XB_TMO], 1u); break; } } } } while (0)
struct XcdBarrier { unsigned* bar; unsigned x; volatile LAS unsigned* st; };
__device__ __forceinline__ XcdBarrier xcd_barrier_post(unsigned* bar, volatile LAS unsigned* st) {
    XcdBarrier b; b.bar = bar; b.x = xb_xcc_id(); b.st = st;
    if (threadIdx.x == 0) (void)xb_add(&bar[XB_XCNT(b.x)], 1u);
    return b;
}
__device__ __forceinline__ void xcd_barrier_complete(unsigned* bar, unsigned x, unsigned& nloc, unsigned& nx) {
    const unsigned G = gridDim.x * gridDim.y * gridDim.z;
    unsigned sum, cnt, mine, sp = 0u;
    for (;;) {
        sum = 0u; cnt = 0u; mine = 0u;
#pragma unroll
        for (unsigned j = 0; j < 16; ++j) { const unsigned c = xb_ld(&bar[XB_XCNT(j)]); sum += c; cnt += (c > 0u) ? 1u : 0u; mine = (j == x) ? c : mine; }
        if (sum == G) break;
        __builtin_amdgcn_s_sleep(1);
        if ((++sp & 255u) == 0u) { if (xb_ld(&bar[XB_TMO])) break; if (sp > XB_SPIN_CAP) { atomicAdd(&bar[XB_TMO], 1u); break; } }
    }
    nloc = mine > 0u ? mine : 1u; nx = cnt > 0u ? cnt : 1u;
}
__device__ __forceinline__ void xcd_barrier(const XcdBarrier& b) {
    asm volatile("s_waitcnt vmcnt(0)" ::: "memory");
    __syncthreads();
    if (threadIdx.x == 0) {
        unsigned* bar = b.bar;
        __builtin_amdgcn_s_waitcnt(0);
        unsigned nloc = b.st[0], nx = b.st[1];
        if (nloc == 0u) { xcd_barrier_complete(bar, b.x, nloc, nx); b.st[0] = nloc; b.st[1] = nx; }
        const unsigned old = xb_add(&bar[XB_XSUB(b.x)], 1u);
        const unsigned gen = old / nloc;
        if (old + 1u == (gen + 1u) * nloc) {
            __builtin_amdgcn_fence(__ATOMIC_RELEASE, "agent");
            asm volatile("s_waitcnt vmcnt(0)" ::: "memory");
            const unsigned og = xb_add(&bar[XB_TOP], 1u);
            const unsigned tg = og / nx;
            if (og + 1u == (tg + 1u) * nx) xb_add(&bar[XB_TOPGEN], 1u);
            else XB_SPIN(xb_ld(&bar[XB_TOPGEN]) == tg, bar);
            __builtin_amdgcn_fence(__ATOMIC_ACQUIRE, "agent");
            xb_add(&bar[XB_XGEN(b.x)], 1u);
            asm volatile("s_waitcnt vmcnt(0)" ::: "memory");
        } else {
            XB_SPIN(xb_ld(&bar[XB_XGEN(b.x)]) == gen, bar);
            __builtin_amdgcn_fence(__ATOMIC_ACQUIRE, "agent");
            asm volatile("s_waitcnt vmcnt(0)" ::: "memory");
        }
    }
    __syncthreads();
}

struct Args { const float* in[17]; float* out; unsigned char* ws; int ph_lo, ph_hi; };
enum { I_X = 0, I_WIN, I_BF, I_DLAM, I_SUBG, I_WO, I_LN1G, I_LN1B, I_WRG, I_BRG, I_WRE, I_BRE, I_WG, I_WU, I_WDN, I_LN2G, I_LN2B };

__device__ __forceinline__ void transpose_item(const float* src, int ldw, bf16_t* dst, int ldd, LAS float* scr, int lane) {
#pragma unroll 8
    for (int i = 0; i < 32; ++i) { const int kk = 2 * i + (lane >> 5); scr[kk * 33 + (lane & 31)] = src[(size_t)kk * ldw + (lane & 31)]; }
    LDS_WAIT(); asm volatile("" ::: "memory");
    const int c = lane & 7;
#pragma unroll
    for (int j = 0; j < 4; ++j) { const int n = (lane >> 3) + 8 * j; const LAS float* s = scr + (8 * c) * 33 + n;
        u32x4 o; o.x = pk2(s[0 * 33], s[1 * 33]); o.y = pk2(s[2 * 33], s[3 * 33]); o.z = pk2(s[4 * 33], s[5 * 33]); o.w = pk2(s[6 * 33], s[7 * 33]);
        *(GAS u32x4*)(dst + (size_t)n * ldd + 8 * c) = o; }
    LDS_WAIT(); asm volatile("" ::: "memory");
}

template <int NT>
__device__ __forceinline__ void skinny_logits(const bf16_t* X, const bf16_t* Wt, LAS float* part, LAS float* logits, int tid) {
    const int lane = tid & 63, wid = __builtin_amdgcn_readfirstlane(tid >> 6), r = lane & 15, kq = lane >> 4;
    f32x4 acc[4][NT];
#pragma unroll
    for (int mt = 0; mt < 4; ++mt)
#pragma unroll
        for (int nt = 0; nt < NT; ++nt) acc[mt][nt] = (f32x4){0.f, 0.f, 0.f, 0.f};
    const bf16_t* ap = X + (size_t)r * DM + wid * 256 + kq * 8;
    const bf16_t* bp = Wt + (size_t)r * DM + wid * 256 + kq * 8;
#pragma unroll 2
    for (int ks = 0; ks < 8; ++ks) {
        bf16x8 a[4], b[NT];
#pragma unroll
        for (int mt = 0; mt < 4; ++mt) a[mt] = *(const GAS bf16x8*)(ap + (size_t)mt * 16 * DM + ks * 32);
#pragma unroll
        for (int nt = 0; nt < NT; ++nt) b[nt] = *(const GAS bf16x8*)(bp + (size_t)nt * 16 * DM + ks * 32);
#pragma unroll
        for (int mt = 0; mt < 4; ++mt)
#pragma unroll
            for (int nt = 0; nt < NT; ++nt) acc[mt][nt] = __builtin_amdgcn_mfma_f32_16x16x32_bf16(a[mt], b[nt], acc[mt][nt], 0, 0, 0);
    }
    constexpr int LW = 16 * NT;
#pragma unroll
    for (int mt = 0; mt < 4; ++mt)
#pragma unroll
        for (int nt = 0; nt < NT; ++nt)
#pragma unroll
            for (int g = 0; g < 4; ++g) part[(wid * 64 + mt * 16 + 4 * kq + g) * LW + nt * 16 + r] = acc[mt][nt][g];
    __syncthreads();
    for (int o = tid; o < 64 * LW; o += 512) { float s = 0.f;
#pragma unroll
        for (int w = 0; w < 8; ++w) s += part[w * 64 * LW + o];
        logits[o] = s; }
    __syncthreads();
}

__device__ __forceinline__ att::BlockRef<att::bf16> fox_ref(int L, int pass, const bf16_t* FQ, const bf16_t* FK, const bf16_t* FV, bf16_t* MRG) {
    const int bh = L >> 4, x = L & 15, qb = pass ? 31 - x : x, b = bh >> 3, h = bh & 7;
    const size_t rowb = (size_t)b * SEQ; att::BlockRef<att::bf16> r;
    r.Q = (const att::bf16*)FQ + (rowb + (size_t)qb * 256) * att::KP + h * HD; r.K = (const att::bf16*)FK + rowb * att::KP + h * HD; r.V = (const att::bf16*)FV + rowb * att::KP + h * HD;
    r.O = (att::bf16*)MRG + (rowb + (size_t)qb * 256) * att::OP + h * HD; r.P0 = qb * 256; r.jlo = 0; return r;
}
__device__ __forceinline__ att::BlockRef<float> dif_ref(int L, int pass, const bf16_t* DQ, const bf16_t* DK, const bf16_t* DV, float* OD) {
    const int vh = L >> 4, x = L & 15, qb = pass ? 31 - x : x, v = vh & 1, j = (vh >> 1) & 1, h = (vh >> 2) & 3, b = vh >> 4;
    const size_t rowb = (size_t)b * SEQ; att::BlockRef<float> r;
    r.Q = (const att::bf16*)DQ + (rowb + (size_t)qb * 256) * att::KP + (2 * h + j) * HD; r.K = (const att::bf16*)DK + rowb * att::KP + (2 * h + j) * HD;
    r.V = (const att::bf16*)DV + rowb * att::KP + h * 256 + v * HD;
    r.O = OD + (rowb + (size_t)qb * 256) * att::OP + h * 512 + j * 256 + v * HD; r.P0 = qb * 256; r.jlo = 0; return r;
}

__global__ void __launch_bounds__(512, 2) trunk_fwd(Args args) {
    extern __shared__ __attribute__((aligned(16))) unsigned char lds_raw[];
    LAS unsigned char* lds = (LAS unsigned char*)lds_raw;
    const int G = gridDim.x, bx = blockIdx.x;
    const int vcu = (G % 8 == 0) ? (bx % 8) * (G / 8) + bx / 8 : bx;
    volatile LAS unsigned* MISC = (volatile LAS unsigned*)(lds + MISC_OFF);
    if (threadIdx.x < 32) MISC[threadIdx.x] = 0u;
    __syncthreads();
#define PHASE_LOCALS const int tid = opaque_tid(), lane = tid & 63, wave = __builtin_amdgcn_readfirstlane(tid >> 6); unsigned char* ws = opaque_ptr(args.ws); unsigned* ctl = (unsigned*)(ws + WS_CTL); (void)lane; (void)wave; (void)ctl;
    const int lo = args.ph_lo, hi = args.ph_hi;
    const bool use_bar = (hi - lo) > 1;
    XcdBarrier bar; bar.bar = (unsigned*)(args.ws + WS_CTL) + CW_BAR; bar.x = 0; bar.st = nullptr;
    if (use_bar) bar = xcd_barrier_post((unsigned*)(args.ws + WS_CTL) + CW_BAR, MISC + 8);
#ifndef PH_MASK
#define PH_MASK 0x1ff
#endif
#define PHK(k) ((k) == 0 ? 0 : (((k) - 1) % 8) + 1)
#define IN(k) (((PH_MASK >> PHK(k)) & 1) && lo <= (k) && (k) < hi)
#define BOTH(k) (IN(k) && IN((k) + 1))
#define GRID_BAR() do { xcd_barrier(bar); } while (0)

#define WIN_T ((bf16_t*)(ws + WS_WIN))
#define WO_T ((bf16_t*)(ws + WS_WO))
#define WGU_T ((bf16_t*)(ws + WS_WGU))
#define WD_T ((bf16_t*)(ws + WS_WD))
#define WF_T ((bf16_t*)(ws + WS_WF))
#define WR_T ((bf16_t*)(ws + WS_WR))
#define COS ((float*)(ws + WS_COS))
#define SIN ((float*)(ws + WS_SIN))
#define LOGF ((float*)(ws + WS_LOGF))
#define TOK ((unsigned*)(ws + WS_TOK))
#define LIST ((int*)(ws + WS_LIST))
#define PB ((float*)(ws + WS_P))
#define QBUF ((float*)(ws + WS_Q))
#define XB ((bf16_t*)(ws + WS_XB))
#define PROJ ((bf16_t*)(ws + WS_PROJ))
#define MRG ((bf16_t*)(ws + WS_MRG))
#define OD ((float*)(ws + WS_OD))
#define HID ((bf16_t*)(ws + WS_HID))
#define YS ((bf16_t*)(ws + WS_YS))
    constexpr size_t PSTR = (size_t)M * 1024;
#define FQ (PROJ)
#define FK (PROJ + PSTR)
#define FV (PROJ + 2 * PSTR)
#define DQ (PROJ + 3 * PSTR)
#define DK (PROJ + 4 * PSTR)
#define DV (PROJ + 5 * PSTR)
    LAS int* utab = (LAS int*)(lds + T_UTAB); LAS unsigned* rowtab = (LAS unsigned*)(lds + T_ROWTAB);
#define x_in (args.in[I_X])
#define FILL_STATIC(Mr, Nc) do { if (tid < 64) { pg8::StaticOrder SO; SO.init(Mr, Nc, G, bx); pg8::Unit u_; u_.pm = 0; u_.pn = 0; const bool ok_ = (tid < 8) && SO.next(tid, u_); \
        if (tid < 8) { utab[2 * tid] = u_.pm; utab[2 * tid + 1] = u_.pn; } const unsigned long long m_ = __ballot(ok_); if (tid == 0) ((LAS int*)(lds + T_MISC))[1] = __popcll(m_); } __syncthreads(); } while (0)
#define FILL_GROUPED(U_, sh_) do { if (tid < 64) { pg8::Unit u_; u_.pm = 0; u_.pn = 0; const bool ok_ = (tid < 8) && pg8::grouped_unit(U_, bx % 8, bx / 8, G / 8, sh_, chunk_e, tid, u_); \
        if (tid < 8) { utab[2 * tid] = u_.pm; utab[2 * tid + 1] = u_.pn; } const unsigned long long m_ = __ballot(ok_); if (tid == 0) tmisc[1] = __popcll(m_); } __syncthreads(); } while (0)
    if (IN(0)) {
        PHASE_LOCALS
        LAS float* scr = (LAS float*)(lds + wave * 16384);
        const int gw = vcu * 8 + wave, NGW = G * 8;
        constexpr int I_A = DEPTH * 32 * 192, I_B = DEPTH * 32 * 64, I_C = DEPTH * NE * 32 * 16, I_E = DEPTH * NE * 8 * 64;
        constexpr int NITEMS = I_A + I_B + 2 * I_C + I_E;
        for (int it = gw; it < NITEMS; it += NGW) {
            int r = it;
            if (r < I_A) { const int l = r / (32 * 192), rem = r % (32 * 192), kb = rem / 192, nb = rem % 192; const int n0 = 32 * nb, sc0 = n0 + (n0 >= 3072 ? 8 : 0);
                transpose_item(args.in[I_WIN] + (size_t)l * DM * INW + (size_t)(64 * kb) * INW + sc0, INW, WIN_T + (size_t)l * NPROJ * DM + (size_t)n0 * DM + 64 * kb, DM, scr, lane); continue; }
            r -= I_A;
            if (r < I_B) { const int l = r / (32 * 64), rem = r % (32 * 64), kb = rem / 64, nb = rem % 64;
                transpose_item(args.in[I_WO] + (size_t)l * DM * DM + (size_t)(64 * kb) * DM + 32 * nb, DM, WO_T + (size_t)l * DM * DM + (size_t)(32 * nb) * DM + 64 * kb, DM, scr, lane); continue; }
            r -= I_B;
            if (r < 2 * I_C) { const int up = r >= I_C ? 1 : 0; if (up) r -= I_C; const int le = r / 512, rem = r % 512, kb = rem / 16, nb = rem % 16;
                const float* src = (up ? args.in[I_WU] : args.in[I_WG]) + (size_t)le * DM * DE + (size_t)(64 * kb) * DE + 32 * nb;
                const int drow = 256 * (nb >> 2) + 32 * (nb & 3) + 128 * up;
                transpose_item(src, DE, WGU_T + (size_t)le * 1024 * DM + (size_t)drow * DM + 64 * kb, DM, scr, lane); continue; }
            r -= 2 * I_C;
            { const int le = r / 512, rem = r % 512, kb = rem / 64, nb = rem % 64;
                transpose_item(args.in[I_WDN] + (size_t)le * DE * DM + (size_t)(64 * kb) * DM + 32 * nb, DM, WD_T + (size_t)le * DM * DE + (size_t)(32 * nb) * DE + 64 * kb, DE, scr, lane); }
        }
        const int gt = vcu * 512 + tid, NGT = G * 512;
        for (int idx = gt; idx < DEPTH * 16 * DM; idx += NGT) { const int l = idx / (16 * DM), rem = idx % (16 * DM), n = rem / DM, k = rem % DM;
            const float v = (n < 8) ? args.in[I_WIN][(size_t)l * DM * INW + (size_t)k * INW + 3072 + n] : 0.f; WF_T[idx] = (bf16_t)f2bf(v); }
        for (int idx = gt; idx < DEPTH * 48 * DM; idx += NGT) { const int l = idx / (48 * DM), rem = idx % (48 * DM), n = rem / DM, k = rem % DM;
            float v = 0.f; if (n < 4) v = args.in[I_WRG][(size_t)l * DM * 4 + (size_t)k * 4 + n]; else if (n < 36) v = args.in[I_WRE][(size_t)l * DM * 32 + (size_t)k * 32 + (n - 4)];
            WR_T[idx] = (bf16_t)f2bf(v); }
        for (int idx = gt; idx < SEQ * 16; idx += NGT) { const int pos = idx >> 4, i = idx & 15;
            const double inv = pow(500000.0, -(double)i * (1.0 / 16.0));
            const double ang = (double)pos * inv; COS[idx] = (float)cos(ang); SIN[idx] = (float)sin(ang); }
        for (int idx = gt; idx < M * DM / 8; idx += NGT) { const f32x4 a = *(const GAS f32x4*)(x_in + (size_t)idx * 8), b = *(const GAS f32x4*)(x_in + (size_t)idx * 8 + 4);
            u32x4 w; w.x = pk2(a[0], a[1]); w.y = pk2(a[2], a[3]); w.z = pk2(b[0], b[1]); w.w = pk2(b[2], b[3]); *(GAS u32x4*)(XB + (size_t)idx * 8) = w; }
        if (BOTH(0)) GRID_BAR();
    }

    for (int l = 0; l < DEPTH; ++l) {
        const int pb = 1 + 8 * l;
        const float lam_init = 0.8f - 0.6f * expf(-0.3f * (float)l);
#define Pin ((l == 0) ? x_in : (const float*)PB)
#define Pout ((l == DEPTH - 1) ? args.out : PB)
#define cnt (ctl + CW_CNT + l * 32 * 16)

        if (IN(pb + 0)) {
            PHASE_LOCALS
            LAS float* part = (LAS float*)(lds + 16384); LAS float* logits = (LAS float*)(lds + 114688);
            for (int tile = bx; tile < M / 64; tile += G) {
                skinny_logits<1>(XB + (size_t)tile * 64 * DM, WF_T + (size_t)l * 16 * DM, part, logits, tid);
                if (tid < 64) { const int token = tile * 64 + tid, b = token / SEQ, pos = token % SEQ;
#pragma unroll
                    for (int h = 0; h < 8; ++h) { const float z = logits[tid * 16 + h] + args.in[I_BF][l * 8 + h];
                        const float lf = fminf(z, 0.f) - log1pf(__expf(-fabsf(z)));
                        LOGF[(size_t)(b * 8 + h) * SEQ + pos] = lf; } }
                __syncthreads();
            }
            FILL_STATIC(M, NPROJ);
            pg8::Gemm g{XB, WIN_T + (size_t)l * NPROJ * DM, DM}; pg8::TabOrder S{((LAS int*)(lds + T_MISC))[1], utab, rowtab};
            pg8::EpiInProj E{ws, l};
            pg8::gemm_phase<pg8::EpiInProj, pg8::TabOrder, false>(lds, g, S, E);
            if (BOTH(pb + 0)) GRID_BAR();
        }

        if (IN(pb + 1)) {
            PHASE_LOCALS
            char* alds = (char*)lds_raw;
#ifndef NO_DIF
            {
                typedef att::BlockRef<float> BR;
                constexpr int TOTAL = BATCH * DIFH * 4 * 16;
                int L = vcu;
                if (L < TOTAL) {
                    int pass = 0; BR cur = dif_ref(L, 0, DQ, DK, DV, OD); att::Seam S; att::prime<float>(cur, alds, S);
                    for (;;) {
                        const bool more_pass = pass == 0, more_item = L + G < TOTAL, last = !more_pass && !more_item;
                        const int passn = more_pass ? 1 : 0, Ln = more_pass ? L : (more_item ? L + G : L);
                        const BR nxt = last ? cur : dif_ref(Ln, passn, DQ, DK, DV, OD);
                        att::block<float, false>(cur, nxt, alds, S);
                        if (last) break;
                        cur = nxt; pass = passn; L = Ln;
                    }
                }
            }
#endif
#ifndef NO_FOX
            {
                typedef att::BlockRef<att::bf16> BR;
                constexpr int TOTAL = BATCH * FOXH * 16;
                LAS int* tm = (LAS int*)(lds + T_MISC);
                if (tid < 16) { const float key = args.in[I_BF][l * 8 + (tid & 7)]; int rank = 0;
#pragma unroll
                    for (int o = 0; o < 16; ++o) { const float ko = args.in[I_BF][l * 8 + (o & 7)]; rank += ((ko > key) || (ko == key && o < tid)) ? 1 : 0; }
                    tm[4 + rank] = tid; }
                __syncthreads();
                for (;;) {
                    if (tid == 0) tm[2] = (int)__hip_atomic_fetch_add(ctl + CW_QHEAD + l * 16, 1u, RLX_AGENT);
                    __syncthreads();
                    const int it = __builtin_amdgcn_readfirstlane(tm[2]);
                    if (it >= TOTAL) break;
                    const int bh = __builtin_amdgcn_readfirstlane(tm[4 + (it >> 4)]); const int L = bh * 16 + (it & 15);
                    att::fox_load_c(LOGF + (size_t)bh * SEQ, alds, tid); __syncthreads();
                    float smax = 0.f;
#pragma unroll
                    for (int g4 = 0; g4 < 4; ++g4) { const float q2 = __uint_as_float(__hip_atomic_load(ctl + CW_NMAX + l * 256 + (bh * 4 + g4) * 2, RLX_AGENT)), k2 = __uint_as_float(__hip_atomic_load(ctl + CW_NMAX + l * 256 + (bh * 4 + g4) * 2 + 1, RLX_AGENT)); smax += sqrtf(q2 * k2); }
                    const float thr = (FOX_PRUNE_T + 2.f * (smax * att::SCALE * 1.02f)) * 11.313708498984761f;
                    BR b0 = fox_ref(L, 0, FQ, FK, FV, MRG), b1 = fox_ref(L, 1, FQ, FK, FV, MRG);
                    b0.jlo = att::fox_jlo(alds, b0.P0, thr); b1.jlo = att::fox_jlo(alds, b1.P0, thr);
                    att::Seam S; att::prime<att::bf16>(b0, alds, S);
                    att::block<att::bf16, true>(b0, b1, alds, S);
                    att::block<att::bf16, true>(b1, b1, alds, S);
                }
            }
#endif
            if (BOTH(pb + 1)) GRID_BAR();
        }

        if (IN(pb + 2)) {
            PHASE_LOCALS
            const float* lv = args.in[I_DLAM] + l * 4 * HD;
            float d1 = lv[lane] * lv[HD + lane] + lv[64 + lane] * lv[HD + 64 + lane], d2 = lv[2 * HD + lane] * lv[3 * HD + lane] + lv[2 * HD + 64 + lane] * lv[3 * HD + 64 + lane];
            d1 = wave_sum(d1); d2 = wave_sum(d2);
            const float lam = __expf(d1) - __expf(d2) + lam_init;
            const f32x4 gsub = *(const f32x4*)(args.in[I_SUBG] + l * 256 + 4 * lane);
            const float osc = 1.f - lam_init;
            const int gw = vcu * 8 + wave, NGW = G * 8;
            for (int task = gw; task < M * DIFH; task += NGW) { const int row = task >> 2, h = task & 3;
                const float* src = OD + (size_t)row * 2048 + h * 512 + 4 * lane;
                const f32x4 o1 = *(const GAS f32x4*)src, o2 = *(const GAS f32x4*)(src + 256);
                const f32x4 d = o1 - o2 * lam;
                const float ss = wave_sum((d[0] * d[0] + d[1] * d[1]) + (d[2] * d[2] + d[3] * d[3]));
                const float rs = (1.0f / sqrtf(ss * (1.f / 256.f) + RMS_EPS)) * osc;
                const f32x4 y = d * gsub * rs;
                u32x2 w; w.x = cvt_pk_bf16(y[0], y[1]); w.y = cvt_pk_bf16(y[2], y[3]);
                *(GAS u32x2*)(MRG + (size_t)row * DM + 1024 + h * 256 + 4 * lane) = w; }
            if (BOTH(pb + 2)) GRID_BAR();
        }

        if (IN(pb + 3)) {
            PHASE_LOCALS
            FILL_STATIC(M, DM);
            pg8::Gemm g{MRG, WO_T + (size_t)l * DM * DM, DM}; pg8::TabOrder S{((LAS int*)(lds + T_MISC))[1], utab, rowtab};
            pg8::EpiRes E{Pin, QBUF, ALPHA};
            pg8::gemm_phase<pg8::EpiRes, pg8::TabOrder, false>(lds, g, S, E);
            if (BOTH(pb + 3)) GRID_BAR();
        }

        if (IN(pb + 4)) {
            PHASE_LOCALS
            LAS float* gl = (LAS float*)lds; LAS float* bl = (LAS float*)(lds + 8192);
            LAS float* part = (LAS float*)(lds + 16384); LAS float* logits = (LAS float*)(lds + 114688);
            LAS int* hist = (LAS int*)(lds + T_HIST); LAS int* basee = (LAS int*)(lds + T_BASE);
            for (int i = tid; i < DM; i += 512) { gl[i] = args.in[I_LN1G][l * DM + i]; bl[i] = args.in[I_LN1B][l * DM + i]; }
            __syncthreads();
            for (int tile = bx; tile < M / 64; tile += G) {
                for (int rr = 0; rr < 8; ++rr) { const int row = tile * 64 + wave * 8 + rr;
                    GAS f32x4* xr = (GAS f32x4*)(QBUF + (size_t)row * DM) + lane;
                    f32x4 v[8]; float s = 0.f;
#pragma unroll
                    for (int j = 0; j < 8; ++j) { v[j] = xr[64 * j]; s += (v[j][0] + v[j][1]) + (v[j][2] + v[j][3]); }
                    const float mean = wave_sum(s) * (1.f / DM); float s2 = 0.f;
#pragma unroll
                    for (int j = 0; j < 8; ++j) { v[j] = v[j] - mean; s2 += (v[j][0] * v[j][0] + v[j][1] * v[j][1]) + (v[j][2] * v[j][2] + v[j][3] * v[j][3]); }
                    const float rstd = 1.f / sqrtf(wave_sum(s2) * (1.f / DM) + LN_EPS);
                    GAS u32x2* o8 = (GAS u32x2*)(XB + (size_t)row * DM) + lane;
#pragma unroll
                    for (int j = 0; j < 8; ++j) { const f32x4 gg = *(const LAS f32x4*)(gl + 256 * j + 4 * lane), bb = *(const LAS f32x4*)(bl + 256 * j + 4 * lane);
                        const f32x4 y = v[j] * rstd * gg + bb; xr[64 * j] = y;
                        u32x2 w; w.x = cvt_pk_bf16(y[0], y[1]); w.y = cvt_pk_bf16(y[2], y[3]); o8[64 * j] = w; }
                }
                if (tid < 32) hist[tid] = 0;
                VM_WAIT(); __syncthreads();
                skinny_logits<3>(XB + (size_t)tile * 64 * DM, WR_T + (size_t)l * 48 * DM, part, logits, tid);
                int e0 = 0, e1 = 0, lr0 = 0, lr1 = 0; float w0 = 0.f, w1 = 0.f;
                if (tid < 64) {
                    const LAS float* lg = logits + tid * 48;
                    float gv[4]; int gs = 0; float gm;
#pragma unroll
                    for (int q = 0; q < 4; ++q) gv[q] = lg[q] + args.in[I_BRG][l * 4 + q];
                    gm = gv[0];
#pragma unroll
                    for (int q = 1; q < 4; ++q) if (gv[q] > gm) { gm = gv[q]; gs = q; }
                    float gsum = 0.f;
#pragma unroll
                    for (int q = 0; q < 4; ++q) gsum += __expf(gv[q] - gm);
                    const float gw_ = 1.f / gsum;
                    float ev[8];
#pragma unroll
                    for (int q = 0; q < 8; ++q) ev[q] = lg[4 + gs * 8 + q] + args.in[I_BRE][l * 32 + gs * 8 + q];
                    int ia = 0; float va = ev[0];
#pragma unroll
                    for (int q = 1; q < 8; ++q) if (ev[q] > va) { va = ev[q]; ia = q; }
                    int ib = -1; float vb = -3.0e38f;
#pragma unroll
                    for (int q = 0; q < 8; ++q) if (q != ia && ev[q] > vb) { vb = ev[q]; ib = q; }
                    const float eb = __expf(vb - va), den = 1.f / (1.f + eb);
                    w0 = gw_ * den; w1 = gw_ * eb * den;
                    e0 = gs * 8 + ia; e1 = gs * 8 + ib;
                    lr0 = __hip_atomic_fetch_add(&hist[e0], 1, __ATOMIC_RELAXED, __HIP_MEMORY_SCOPE_WORKGROUP); lr1 = __hip_atomic_fetch_add(&hist[e1], 1, __ATOMIC_RELAXED, __HIP_MEMORY_SCOPE_WORKGROUP);
                }
                __syncthreads();
                if (tid < 32) { const int n = hist[tid]; int b0 = 0; if (n > 0) b0 = (int)__hip_atomic_fetch_add(cnt + tid * 16, (unsigned)n, RLX_AGENT); basee[tid] = b0; }
                __syncthreads();
                if (tid < 64) { const int token = tile * 64 + tid; const int r0 = basee[e0] + lr0, r1 = basee[e1] + lr1;
                    LIST[e0 * M + r0] = token; LIST[e1 * M + r1] = token;
                    u32x4 ta; ta.x = (unsigned)e0; ta.y = (unsigned)r0; ta.z = (unsigned)e1; ta.w = (unsigned)r1;
                    u32x4 tb; tb.x = __float_as_uint(w0); tb.y = __float_as_uint(w1); tb.z = 0u; tb.w = 0u;
                    *(GAS u32x4*)(TOK + (size_t)token * 8) = ta; *(GAS u32x4*)(TOK + (size_t)token * 8 + 4) = tb; }
                __syncthreads();
            }
            if (BOTH(pb + 4)) GRID_BAR();
        }

        if (IN(pb + 5) || IN(pb + 6)) {
            PHASE_LOCALS
            LAS int* chunk_e = (LAS int*)(lds + T_CHUNK_E); LAS int* tmisc = (LAS int*)(lds + T_MISC);
            LAS int* pstart = (LAS int*)(lds + T_PSTART);
            if (tid == 0) { int C = 0;
_Pragma("nounroll")
                for (int e = 0; e < NE; ++e) { const int n = (int)__hip_atomic_load(cnt + e * 16, RLX_AGENT); const int nch = (n + 255) >> 8; pstart[e] = C;
_Pragma("nounroll")
                    for (int c = 0; c < nch; ++c) chunk_e[C + c] = e; C += nch; } tmisc[0] = C; }
            __syncthreads();
            const int C = tmisc[0];
            if (IN(pb + 5)) {
                FILL_GROUPED(C * 4, 2);
                const int nu = tmisc[1];
_Pragma("nounroll")
                for (int i = 0; i < nu; ++i) { const int pm_ = utab[2 * i], e = utab[2 * i + 1] >> 2, r0 = (pm_ - pstart[e]) * 256; const int n = (int)__hip_atomic_load(cnt + e * 16, RLX_AGENT);
                    for (int r = tid; r < 256; r += 512) { const int rk = (r0 + r < n) ? r0 + r : r0; rowtab[i * 256 + r] = (unsigned)LIST[e * M + rk] * (unsigned)(DM * 2); } }
                __syncthreads();
                pg8::TabOrder S{nu, utab, rowtab};
                pg8::Gemm g{XB, WGU_T + (size_t)l * NE * 1024 * DM, DM};
                pg8::EpiSwiGLU E{HID};
                pg8::gemm_phase<pg8::EpiSwiGLU, pg8::TabOrder, true>(lds, g, S, E);
                if (BOTH(pb + 5)) GRID_BAR();
            }
            if (IN(pb + 6)) {
                FILL_GROUPED(C * 8, 3);
                pg8::TabOrder S{tmisc[1], utab, rowtab};
                pg8::Gemm g{HID, WD_T + (size_t)l * NE * DM * DE, DE};
                pg8::EpiDown E{YS};
                pg8::gemm_phase<pg8::EpiDown, pg8::TabOrder, false>(lds, g, S, E);
                if (BOTH(pb + 6)) GRID_BAR();
            }
        }

        if (IN(pb + 7)) {
            PHASE_LOCALS
            LAS float* gl = (LAS float*)lds; LAS float* bl = (LAS float*)(lds + 8192); LAS int* pstart = (LAS int*)(lds + T_PSTART);
            for (int i = tid; i < DM; i += 512) { gl[i] = args.in[I_LN2G][l * DM + i]; bl[i] = args.in[I_LN2B][l * DM + i]; }
            if (tid == 0) { int C = 0;
_Pragma("nounroll")
                for (int e = 0; e < NE; ++e) { const int n = (int)__hip_atomic_load(cnt + e * 16, RLX_AGENT); pstart[e] = C * 256; C += (n + 255) >> 8; } }
            __syncthreads();
            const int gw = vcu * 8 + wave, NGW = G * 8;
            for (int row = gw; row < M; row += NGW) {
                const u32x4 ta = *(const GAS u32x4*)(TOK + (size_t)row * 8); const u32x2 tb = *(const GAS u32x2*)(TOK + (size_t)row * 8 + 4);
                const int s0 = pstart[ta.x] + (int)ta.y, s1 = pstart[ta.z] + (int)ta.w; const float w0 = __uint_as_float(tb.x), w1 = __uint_as_float(tb.y);
                const GAS f32x4* xr = (const GAS f32x4*)(QBUF + (size_t)row * DM) + lane;
                const GAS u32x2* y0 = (const GAS u32x2*)(YS + (size_t)s0 * DM) + lane; const GAS u32x2* y1 = (const GAS u32x2*)(YS + (size_t)s1 * DM) + lane;
                f32x4 v[8]; float s = 0.f;
#pragma unroll
                for (int j = 0; j < 8; ++j) { const f32x4 xx = xr[64 * j]; const u32x2 a = y0[64 * j], b = y1[64 * j];
                    f32x4 t; t[0] = xx[0] * ALPHA + (w0 * bf_lo(a.x) + w1 * bf_lo(b.x)); t[1] = xx[1] * ALPHA + (w0 * bf_hi(a.x) + w1 * bf_hi(b.x));
                    t[2] = xx[2] * ALPHA + (w0 * bf_lo(a.y) + w1 * bf_lo(b.y)); t[3] = xx[3] * ALPHA + (w0 * bf_hi(a.y) + w1 * bf_hi(b.y));
                    v[j] = t; s += (t[0] + t[1]) + (t[2] + t[3]); }
                const float mean = wave_sum(s) * (1.f / DM); float s2 = 0.f;
#pragma unroll
                for (int j = 0; j < 8; ++j) { v[j] = v[j] - mean; s2 += (v[j][0] * v[j][0] + v[j][1] * v[j][1]) + (v[j][2] * v[j][2] + v[j][3] * v[j][3]); }
                const float rstd = 1.f / sqrtf(wave_sum(s2) * (1.f / DM) + LN_EPS);
                GAS f32x4* po = (GAS f32x4*)(Pout + (size_t)row * DM) + lane; GAS u32x2* o8 = (GAS u32x2*)(XB + (size_t)row * DM) + lane;
#pragma unroll
                for (int j = 0; j < 8; ++j) { const f32x4 gg = *(const LAS f32x4*)(gl + 256 * j + 4 * lane), bb = *(const LAS f32x4*)(bl + 256 * j + 4 * lane);
                    const f32x4 y = v[j] * rstd * gg + bb; po[64 * j] = y;
                    u32x2 w; w.x = cvt_pk_bf16(y[0], y[1]); w.y = cvt_pk_bf16(y[2], y[3]); o8[64 * j] = w; }
            }
            if (BOTH(pb + 7)) GRID_BAR();
        }
    }
#undef IN
#undef BOTH
#undef GRID_BAR
}

extern "C" void kernel_launch(void* const* d_in, const int* in_sizes, int n_in, void* d_out, int out_size, void* d_ws, size_t ws_size, hipStream_t stream) {
    static int grid = 0;
    if (grid == 0) {
        if (n_in != 17 || in_sizes[0] != M * DM || out_size != M * DM || ws_size < WS_END) { fprintf(stderr, "kernel_launch: unexpected shapes (n_in %d in0 %d out %d ws %zu, need ws >= %zu); nothing launched\n", n_in, n_in > 0 ? in_sizes[0] : -1, out_size, ws_size, (size_t)WS_END); grid = -1; return; }
        int dev = 0, cus = 0, per_cu = 0;
        if (hipGetDevice(&dev) != hipSuccess || hipDeviceGetAttribute(&cus, hipDeviceAttributeMultiprocessorCount, dev) != hipSuccess) { grid = -1; return; }
        if (hipFuncSetAttribute((const void*)trunk_fwd, hipFuncAttributeMaxDynamicSharedMemorySize, LDS_BYTES) != hipSuccess) { fprintf(stderr, "kernel_launch: hipFuncSetAttribute failed\n"); grid = -1; return; }
        if (hipOccupancyMaxActiveBlocksPerMultiprocessor(&per_cu, (const void*)trunk_fwd, 512, LDS_BYTES) != hipSuccess || per_cu < 1) fprintf(stderr, "kernel_launch: occupancy query reports %d\n", per_cu);
        (void)hipGetLastError();
        grid = cus;
    }
    if (grid < 0) return;
    if (hipMemsetAsync((char*)d_ws + WS_CTL, 0, CTL_ZERO_BYTES, stream) != hipSuccess) return;
    Args a{};
    for (int i = 0; i < 17; ++i) a.in[i] = (const float*)d_in[i];
    a.out = (float*)d_out; a.ws = (unsigned char*)d_ws;
#if MK_PER_PHASE
    for (int ph = 0; ph < NPHASE; ++ph) { a.ph_lo = ph; a.ph_hi = ph + 1; hipLaunchKernelGGL(trunk_fwd, dim3(grid), dim3(512), LDS_BYTES, stream, a); }
#else
    a.ph_lo = 0; a.ph_hi = NPHASE; hipLaunchKernelGGL(trunk_fwd, dim3(grid), dim3(512), LDS_BYTES, stream, a);
#endif
}
```

```cpp
#include <hip/hip_runtime.h>
#include <hip/hip_bf16.h>
#include <cstdio>
#include <cstdint>

#ifndef MK_PER_PHASE
#define MK_PER_PHASE 0
#endif

constexpr int BATCH = 2, SEQ = 8192, DM = 2048, DEPTH = 4, HD = 128, M = BATCH * SEQ;
constexpr int FOXH = 8, DIFH = 4, NPROJ = 6144, INW = 6152;
constexpr int NE = 32, DE = 512, NSLOT = 40960;
constexpr float LN_EPS = 1e-5f, RMS_EPS = 1e-5f;
constexpr float FOX_PRUNE_T = 30.f;
constexpr float ALPHA = 1.681792830507429f;
constexpr int NPHASE = 1 + 8 * DEPTH;

#define GAS __attribute__((address_space(1)))
#define LAS __attribute__((address_space(3)))
typedef unsigned short bf16_t;
typedef short bf16x8 __attribute__((ext_vector_type(8)));
typedef short s16x4 __attribute__((ext_vector_type(4)));
typedef float f32x4 __attribute__((ext_vector_type(4)));
typedef float f32x2 __attribute__((ext_vector_type(2)));
typedef float f32x16 __attribute__((ext_vector_type(16)));
typedef unsigned u32x4 __attribute__((ext_vector_type(4)));
typedef unsigned u32x2 __attribute__((ext_vector_type(2)));
typedef GAS unsigned gu32;
#define RLX_AGENT __ATOMIC_RELAXED, __HIP_MEMORY_SCOPE_AGENT

constexpr size_t MiB = 1u << 20;
constexpr size_t WS_CTL = 0, CTL_ZERO_BYTES = 65536;
constexpr size_t WS_COS = 1 * MiB, WS_SIN = 1 * MiB + 512 * 1024;
constexpr size_t WS_WF = 2 * MiB, WS_WR = 2 * MiB + 256 * 1024;
constexpr size_t WS_LOGF = 3 * MiB, WS_TOK = 3 * MiB + 512 * 1024;
constexpr size_t WS_LIST = 4 * MiB;
constexpr size_t WS_WIN = 8 * MiB, WS_WO = 104 * MiB, WS_WGU = 136 * MiB, WS_WD = 648 * MiB;
constexpr size_t WS_P = 904 * MiB, WS_Q = 1032 * MiB, WS_XB = 1160 * MiB, WS_PROJ = 1224 * MiB, WS_MRG = 1416 * MiB, WS_OD = 1480 * MiB;
constexpr size_t WS_HID = 1608 * MiB, WS_YS = 1648 * MiB, WS_END = 1808 * MiB;
constexpr int CW_TMO = 0, CW_CNT = 1024, CW_QHEAD = 3072, CW_BAR = 4096, CW_NMAX = 8192;

constexpr int RING_BYTES = 131072;
constexpr int TAB_OFF = RING_BYTES;
constexpr int T_CHUNK_E = TAB_OFF, T_PSTART = TAB_OFF + 1024, T_HIST = TAB_OFF + 1280, T_BASE = TAB_OFF + 1536, T_MISC = TAB_OFF + 1792, T_UTAB = TAB_OFF + 1856, T_ROWTAB = TAB_OFF + 2048;
constexpr int MISC_OFF = 147456 - 128;
constexpr int LDS_BYTES = 147456;

__device__ __forceinline__ unsigned cvt_pk_bf16(float lo, float hi) { unsigned r; asm volatile("v_cvt_pk_bf16_f32 %0, %1, %2" : "=v"(r) : "v"(lo), "v"(hi)); return r; }
__device__ __forceinline__ unsigned f2bf(float f) { unsigned u = __builtin_bit_cast(unsigned, f); return (u + 0x7fffu + ((u >> 16) & 1u)) >> 16; }
__device__ __forceinline__ unsigned pk2(float lo, float hi) { return f2bf(lo) | (f2bf(hi) << 16); }
__device__ __forceinline__ float bf_lo(unsigned w) { return __builtin_bit_cast(float, w << 16); }
__device__ __forceinline__ float bf_hi(unsigned w) { return __builtin_bit_cast(float, w & 0xffff0000u); }
__device__ __forceinline__ float wave_sum(float v) {
#pragma unroll
    for (int o = 1; o < 64; o <<= 1) v += __shfl_xor(v, o);
    return v;
}
__device__ __forceinline__ unsigned char* opaque_ptr(unsigned char* p) { asm volatile("" : "+s"(p)); return p; }
__device__ __forceinline__ int opaque_tid() { int t = threadIdx.x; asm volatile("" : "+v"(t)); return t; }
#define LDS_WAIT() asm volatile("s_waitcnt lgkmcnt(0)" ::: "memory")
#define VM_WAIT() asm volatile("s_waitcnt vmcnt(0)" ::: "memory")

namespace pg8 {
constexpr int BM = 256, BK = 64, HALF = 128, HTB = HALF * BK * 2, STAGE_BYTES = 8 * HTB, NXCD = 8, WGM = 8;
__host__ __device__ __forceinline__ int lds_byte(int r, int c) { const int st = (r >> 4) * 2 + (c >> 5), rr = r & 15, cc = c & 31, ob = rr * 64 + cc * 2; return st * 1024 + (ob ^ (((ob >> 9) & 1) << 5)); }
__host__ __device__ __forceinline__ void stage_rc(int b, int& R, int& C) { const int st = b / 1024, sb = b % 1024, swz = sb ^ (((sb >> 9) & 1) << 5); R = (st >> 1) * 16 + swz / 64; C = (st & 1) * 32 + (swz % 64) / 2; }
__host__ __device__ __forceinline__ int perm32(int rho) { const int n = rho >> 4, i = rho & 15; return 8 * (i >> 2) + 4 * n + (i & 3); }

struct Unit { int pm, pn; };
struct Gemm { const bf16_t* A; const bf16_t* Bt; int K; };

struct StaticOrder {
    int nM, nN, nwg, G, c;
    __device__ __forceinline__ void init(int Mr, int N, int G_, int c_) { nM = Mr / BM; nN = N / BM; nwg = nM * nN; G = G_; c = c_; }
    __device__ __forceinline__ bool next(int i, Unit& u) const {
        const long L = (long)i * G + c; if (L >= nwg) return false;
        int wgid = (int)L; { const int q = nwg / NXCD, r = nwg % NXCD, xcd = wgid % NXCD, off = wgid / NXCD; wgid = (xcd < r ? xcd * (q + 1) : r * (q + 1) + (xcd - r) * q) + off; }
        const int nig = WGM * nN, gid = wgid / nig, fm = gid * WGM, gsz = (nM - fm) < WGM ? (nM - fm) : WGM;
        u.pm = fm + ((wgid % nig) % gsz); u.pn = (wgid % nig) / gsz; return true;
    }
};
struct TabOrder {
    int n; const LAS int* utab; const LAS unsigned* rowtab;
    __device__ __forceinline__ bool next(int i, Unit& u) const { if (i >= n) return false; u.pm = __builtin_amdgcn_readfirstlane(utab[2 * i]); u.pn = __builtin_amdgcn_readfirstlane(utab[2 * i + 1]); return true; }
    __device__ __forceinline__ const LAS unsigned* rows(int i) const { return rowtab + 256 * i; }
};
__device__ __forceinline__ bool grouped_unit(int U, int x, int j, int G8, int ntn_shift, const LAS int* chunk_e, int i, Unit& u) {
    const int q = U / 8, r = U % 8; const int lo = x * q + (x < r ? x : r), sz = q + (x < r ? 1 : 0);
    const int idx = j + i * G8; if (idx >= sz) return false;
    const int L = lo + idx, chunk = L >> ntn_shift, cn = L & ((1 << ntn_shift) - 1);
    u.pm = chunk; u.pn = (chunk_e[chunk] << ntn_shift) + cn; return true;
}

template <class Epi, class Sched, bool GATHER>
__device__ __forceinline__ void gemm_phase(LAS unsigned char* lds, const Gemm g, const Sched& S, const Epi& E) {
    const int tid = opaque_tid(), wid = __builtin_amdgcn_readfirstlane(tid >> 6), lane = tid & 63, wr = wid >> 2, wc = wid & 3, fr = lane & 15, fq = lane >> 4;
    const int K = g.K, nt = K / BK;
    unsigned voffA[2], voffB[2]; int RA[2];
#pragma unroll
    for (int i = 0; i < 2; ++i) { int R, C; stage_rc(tid * 16 + i * 8192, R, C); const int Rb = Epi::PERM ? ((R & ~31) + perm32(R & 31)) : R;
        voffA[i] = GATHER ? (unsigned)(C * 2) : (unsigned)(R * K + C) * 2u; voffB[i] = (unsigned)(Rb * K + C) * 2u; RA[i] = R; }
    const size_t kstep = (size_t)(BK * 2);
    const size_t hstep = (size_t)HALF * K * 2;
    const size_t tstep = 2 * hstep;
    const unsigned ldsw = (unsigned)wid * 1024u;
    const int aoff = lds_byte(wr * 64 + fr, fq * 8), boff = lds_byte(wc * 32 + fr, fq * 8);
#define PG8_SA(b, h) (((b) * 2 + (h)) * HTB)
#define PG8_SB(b, h) ((4 + (b) * 2 + (h)) * HTB)
#define PG8_STAGE2(bufoff, gbase, v0, v1) do { \
        __builtin_amdgcn_global_load_lds((const unsigned*)((const char*)(gbase) + (v0)), (LAS unsigned*)(lds + (bufoff) + ldsw), 16, 0, 0); \
        __builtin_amdgcn_global_load_lds((const unsigned*)((const char*)(gbase) + (v1)), (LAS unsigned*)(lds + (bufoff) + ldsw + 8192), 16, 0, 0); } while (0)
#define PG8_STAGEB(bufoff, gbase) PG8_STAGE2(bufoff, gbase, voffB[0], voffB[1])
#define PG8_STAGEA(bufoff, gbase, h, NX) do { if constexpr (GATHER) { PG8_STAGE2(bufoff, gbase, va[h][0], va[h][1]); } \
        else { PG8_STAGE2(bufoff, (gbase) + (h) * hstep, voffA[0], voffA[1]); } } while (0)
#define PG8_LDA(dst, b, h) do { _Pragma("unroll") for (int m = 0; m < 4; ++m) _Pragma("unroll") for (int k = 0; k < 2; ++k) dst[m][k] = *(const LAS bf16x8*)(lds + PG8_SA(b, h) + aoff + m * 2048 + k * 1024); } while (0)
#define PG8_LDB(dst, b, h) do { _Pragma("unroll") for (int n = 0; n < 2; ++n) _Pragma("unroll") for (int k = 0; k < 2; ++k) dst[n][k] = *(const LAS bf16x8*)(lds + PG8_SB(b, h) + boff + n * 2048 + k * 1024); } while (0)
#define PG8_MMA(ai, bj, At, Bt) do { __builtin_amdgcn_s_setprio(1); _Pragma("unroll") for (int m = 0; m < 4; ++m) _Pragma("unroll") for (int n = 0; n < 2; ++n) _Pragma("unroll") for (int k = 0; k < 2; ++k) \
        acc[ai][bj][m][n] = __builtin_amdgcn_mfma_f32_16x16x32_bf16(Bt[n][k], At[m][k], acc[ai][bj][m][n], 0, 0, 0); __builtin_amdgcn_s_setprio(0); } while (0)
#define PG8_WAIT_V(n) asm volatile("s_waitcnt vmcnt(" #n ")" ::: "memory")
#define PG8_WAIT_L(n) asm volatile("s_waitcnt lgkmcnt(" #n ")" ::: "memory")
#define PG8_BAR __builtin_amdgcn_s_barrier()
#define PG8_SCHED __builtin_amdgcn_sched_barrier(0)
    Unit cur, nxt; int ui = 0;
    if (!S.next(0, cur)) return;
    f32x4 acc[2][2][4][2];
#pragma unroll
    for (int a = 0; a < 2; ++a)
#pragma unroll
        for (int b = 0; b < 2; ++b)
#pragma unroll
            for (int m = 0; m < 4; ++m)
#pragma unroll
                for (int n = 0; n < 2; ++n) acc[a][b][m][n] = (f32x4){0.f, 0.f, 0.f, 0.f};
    bf16x8 At[4][2], B0[2][2], B1[2][2];
    unsigned va[2][2];
    if constexpr (GATHER) { const LAS unsigned* rt = S.rows(0);
#pragma unroll
        for (int h = 0; h < 2; ++h)
#pragma unroll
            for (int i = 0; i < 2; ++i) va[h][i] = rt[h * HALF + RA[i]] + voffA[i]; }
    else { va[0][0] = va[0][1] = va[1][0] = va[1][1] = 0u; }
    const char* cA = GATHER ? (const char*)g.A : (const char*)g.A + (size_t)cur.pm * tstep; const char* cB = (const char*)g.Bt + (size_t)cur.pn * tstep;
    PG8_STAGEB(PG8_SB(0, 0), cB); PG8_STAGEB(PG8_SB(0, 1), cB + hstep); PG8_STAGEA(PG8_SA(0, 0), cA, 0, false); PG8_STAGEA(PG8_SA(0, 1), cA, 1, false);
    if (wr == 1) PG8_BAR;
    PG8_WAIT_V(2); PG8_BAR;
    PG8_STAGEB(PG8_SB(1, 0), cB + kstep); PG8_STAGEA(PG8_SA(1, 0), cA + kstep, 0, false); PG8_STAGEB(PG8_SB(1, 1), cB + hstep + kstep);
    PG8_WAIT_V(6); PG8_BAR;
    for (;;) {
        const bool has_next = S.next(ui + 1, nxt);
        const char* nA = GATHER ? cA : (has_next ? (const char*)g.A + (size_t)nxt.pm * tstep : cA); const char* nB = has_next ? (const char*)g.Bt + (size_t)nxt.pn * tstep : cB;
#pragma nounroll
        for (int t = 0; t < nt; t += 2) {
            const bool last = (t == nt - 2);
            const char* a1 = cA + (size_t)(t + 1) * kstep;
            const char* a2 = last ? nA : cA + (size_t)(t + 2) * kstep; const char* b2 = last ? nB : cB + (size_t)(t + 2) * kstep;
            const char* a3 = a2 + kstep; const char* b3 = b2 + kstep;
            PG8_LDB(B0, 0, 0); PG8_LDB(B1, 0, 1); PG8_SCHED; PG8_LDA(At, 0, 0); PG8_STAGEA(PG8_SA(1, 1), a1, 1, false);
            if constexpr (GATHER) { if (last && has_next) { const LAS unsigned* rt = S.rows(ui + 1);
#pragma unroll
                for (int h = 0; h < 2; ++h)
#pragma unroll
                    for (int i = 0; i < 2; ++i) va[h][i] = rt[h * HALF + RA[i]] + voffA[i]; } }
            PG8_WAIT_V(8); PG8_WAIT_L(0); PG8_BAR; PG8_MMA(0, 0, At, B0); PG8_MMA(0, 1, At, B1); PG8_BAR; PG8_SCHED;
            PG8_LDA(At, 0, 1); PG8_STAGEB(PG8_SB(0, 0), b2); PG8_STAGEB(PG8_SB(0, 1), b2 + hstep); PG8_STAGEA(PG8_SA(0, 0), a2, 0, last);
            PG8_WAIT_V(8); PG8_WAIT_L(0); PG8_BAR; PG8_MMA(1, 0, At, B0); PG8_MMA(1, 1, At, B1); PG8_BAR; PG8_SCHED;
            PG8_LDB(B0, 1, 0); PG8_LDB(B1, 1, 1); PG8_SCHED; PG8_LDA(At, 1, 0); PG8_STAGEA(PG8_SA(0, 1), a2, 1, last);
            PG8_WAIT_V(8); PG8_WAIT_L(0); PG8_BAR; PG8_MMA(0, 0, At, B0); PG8_MMA(0, 1, At, B1); PG8_BAR; PG8_SCHED;
            PG8_LDA(At, 1, 1); PG8_STAGEB(PG8_SB(1, 0), b3); PG8_STAGEB(PG8_SB(1, 1), b3 + hstep); PG8_STAGEA(PG8_SA(1, 0), a3, 0, last);
            PG8_WAIT_V(8); PG8_WAIT_L(0); PG8_BAR; PG8_MMA(1, 0, At, B0); PG8_MMA(1, 1, At, B1); PG8_BAR; PG8_SCHED;
        }
        if (wr == 0) PG8_BAR;
        E(acc, cur, wr, wc, fr, fq);
        if (!has_next) break;
#pragma unroll
        for (int a = 0; a < 2; ++a)
#pragma unroll
            for (int b = 0; b < 2; ++b)
#pragma unroll
                for (int m = 0; m < 4; ++m)
#pragma unroll
                    for (int n = 0; n < 2; ++n) acc[a][b][m][n] = (f32x4){0.f, 0.f, 0.f, 0.f};
        cur = nxt; cA = nA; cB = nB; ++ui;
        if (wr == 1) PG8_BAR;
    }
    PG8_WAIT_V(0);
    PG8_BAR;
#undef PG8_SA
#undef PG8_SB
#undef PG8_STAGE2
#undef PG8_STAGEB
#undef PG8_STAGEA
#undef PG8_LDA
#undef PG8_LDB
#undef PG8_MMA
#undef PG8_WAIT_V
#undef PG8_WAIT_L
#undef PG8_BAR
#undef PG8_SCHED
}

struct EpiInProj {
    static constexpr bool PERM = true;
    unsigned char* wsb; int layer;
    __device__ __forceinline__ void operator()(const f32x4 (&acc)[2][2][4][2], const Unit& u, int wr, int wc, int fr, int fq) const {
        const float* cosT = (const float*)(wsb + WS_COS); const float* sinT = (const float*)(wsb + WS_SIN);
        const int tsel = u.pn >> 2;
        bf16_t* base = (bf16_t*)(wsb + WS_PROJ) + (size_t)tsel * ((size_t)M * 1024) + ((size_t)((u.pm >> 5) * 8 + 2 * (u.pn & 3)) * SEQ) * 128;
        const int row0 = (u.pm & 31) * BM + wr * 64 + fr, col0 = wc * 32 + 8 * fq;
        const bool rope = (tsel == 3 || tsel == 4) && (wc == 0);
        const float sgn = (fq < 2) ? -1.f : 1.f; const int i0 = 8 * (fq & 1);
        if (tsel < 2) {
            float mx0 = 0.f, mx1 = 0.f;
#pragma unroll
            for (int ai = 0; ai < 2; ++ai)
#pragma unroll
                for (int m = 0; m < 4; ++m) {
#pragma unroll
                    for (int bj = 0; bj < 2; ++bj) { const f32x4 v0 = acc[ai][bj][m][0], v1 = acc[ai][bj][m][1];
                        float ss = (v0[0] * v0[0] + v0[1] * v0[1]) + (v0[2] * v0[2] + v0[3] * v0[3]) + (v1[0] * v1[0] + v1[1] * v1[1]) + (v1[2] * v1[2] + v1[3] * v1[3]);
                        ss += __shfl_xor(ss, 16); ss += __shfl_xor(ss, 32);
                        if (bj == 0) mx0 = fmaxf(mx0, ss); else mx1 = fmaxf(mx1, ss); } }
#pragma unroll
            for (int o = 1; o < 16; o <<= 1) { mx0 = fmaxf(mx0, __shfl_xor(mx0, o)); mx1 = fmaxf(mx1, __shfl_xor(mx1, o)); }
            if (fr == 0 && fq == 0) { unsigned* nm = (unsigned*)(wsb + WS_CTL) + CW_NMAX + layer * 256; const int bh0 = (u.pm >> 5) * 8 + 2 * (u.pn & 3);
                __hip_atomic_fetch_max(nm + ((bh0 + 0) * 4 + wc) * 2 + tsel, __float_as_uint(mx0 * 1.02f), RLX_AGENT);
                __hip_atomic_fetch_max(nm + ((bh0 + 1) * 4 + wc) * 2 + tsel, __float_as_uint(mx1 * 1.02f), RLX_AGENT); }
        }
#pragma unroll
        for (int ai = 0; ai < 2; ++ai)
#pragma unroll
            for (int m = 0; m < 4; ++m) { const int row = row0 + ai * HALF + m * 16; bf16_t* rowp = base + (size_t)row * 128 + col0;
                f32x4 c0 = (f32x4){1.f, 1.f, 1.f, 1.f}, c1 = c0, s0 = (f32x4){0.f, 0.f, 0.f, 0.f}, s1 = s0;
                if (rope) { const int pos = row; c0 = *(const f32x4*)(cosT + pos * 16 + i0); c1 = *(const f32x4*)(cosT + pos * 16 + i0 + 4); s0 = *(const f32x4*)(sinT + pos * 16 + i0); s1 = *(const f32x4*)(sinT + pos * 16 + i0 + 4); }
#pragma unroll
                for (int bj = 0; bj < 2; ++bj) { f32x4 v0 = acc[ai][bj][m][0], v1 = acc[ai][bj][m][1];
                    if (rope) { f32x4 p0, p1;
#pragma unroll
                        for (int j = 0; j < 4; ++j) { p0[j] = __shfl_xor(v0[j], 32); p1[j] = __shfl_xor(v1[j], 32); }
                        v0 = v0 * c0 + (p0 * s0) * sgn; v1 = v1 * c1 + (p1 * s1) * sgn; }
                    u32x4 w; w.x = cvt_pk_bf16(v0[0], v0[1]); w.y = cvt_pk_bf16(v0[2], v0[3]); w.z = cvt_pk_bf16(v1[0], v1[1]); w.w = cvt_pk_bf16(v1[2], v1[3]);
                    *(u32x4*)(rowp + (size_t)bj * SEQ * 128) = w; } }
    }
};
struct EpiRes {
    static constexpr bool PERM = false;
    const bf16_t* P; float* Qo; float alpha;
    __device__ __forceinline__ void operator()(const f32x4 (&acc)[2][2][4][2], const Unit& u, int wr, int wc, int fr, int fq) const {
        const int row0 = u.pm * BM + wr * 64 + fr, col0 = u.pn * BM + wc * 32 + 4 * fq;
#pragma unroll
        for (int ai = 0; ai < 2; ++ai)
#pragma unroll
            for (int m = 0; m < 4; ++m) { const size_t off = (size_t)(row0 + ai * HALF + m * 16) * DM + col0;
#pragma unroll
                for (int bj = 0; bj < 2; ++bj)
#pragma unroll
                    for (int n = 0; n < 2; ++n) { const u32x2 r = *(const u32x2*)(P + off + bj * HALF + n * 16); const f32x4 x = (f32x4){bf_lo(r.x), bf_hi(r.x), bf_lo(r.y), bf_hi(r.y)};
                        *(f32x4*)(Qo + off + bj * HALF + n * 16) = x * alpha + acc[ai][bj][m][n]; } }
    }
};
struct EpiSwiGLU {
    static constexpr bool PERM = true;
    bf16_t* H;
    __device__ __forceinline__ void operator()(const f32x4 (&acc)[2][2][4][2], const Unit& u, int wr, int wc, int fr, int fq) const {
        const int row0 = u.pm * BM + wr * 64 + fr, col0 = (u.pn & 3) * HALF + wc * 32 + 8 * fq;
#pragma unroll
        for (int ai = 0; ai < 2; ++ai)
#pragma unroll
            for (int m = 0; m < 4; ++m) { bf16_t* rowp = H + (size_t)(row0 + ai * HALF + m * 16) * DE + col0; float h[8];
#pragma unroll
                for (int n = 0; n < 2; ++n)
#pragma unroll
                    for (int j = 0; j < 4; ++j) { const float gg = acc[ai][0][m][n][j], uu = acc[ai][1][m][n][j];
                        h[n * 4 + j] = gg * uu * __builtin_amdgcn_rcpf(1.f + __builtin_amdgcn_exp2f(-1.4426950408889634f * gg)); }
                u32x4 w; w.x = cvt_pk_bf16(h[0], h[1]); w.y = cvt_pk_bf16(h[2], h[3]); w.z = cvt_pk_bf16(h[4], h[5]); w.w = cvt_pk_bf16(h[6], h[7]);
                *(u32x4*)rowp = w; }
    }
};
struct EpiDown {
    static constexpr bool PERM = true;
    bf16_t* Y;
    __device__ __forceinline__ void operator()(const f32x4 (&acc)[2][2][4][2], const Unit& u, int wr, int wc, int fr, int fq) const {
        const int row0 = u.pm * BM + wr * 64 + fr, col0 = (u.pn & 7) * BM + wc * 32 + 8 * fq;
#pragma unroll
        for (int ai = 0; ai < 2; ++ai)
#pragma unroll
            for (int m = 0; m < 4; ++m) { bf16_t* rowp = Y + (size_t)(row0 + ai * HALF + m * 16) * DM + col0;
#pragma unroll
                for (int bj = 0; bj < 2; ++bj) { const f32x4 v0 = acc[ai][bj][m][0], v1 = acc[ai][bj][m][1];
                    u32x4 w; w.x = cvt_pk_bf16(v0[0], v0[1]); w.y = cvt_pk_bf16(v0[2], v0[3]); w.z = cvt_pk_bf16(v1[0], v1[1]); w.w = cvt_pk_bf16(v1[2], v1[3]);
                    *(u32x4*)(rowp + bj * HALF) = w; } }
    }
};
}

namespace att {
using bf16 = __hip_bfloat16;
constexpr int D = 128, KP = 128, OP = 2048;
constexpr float SCALE = 0.08838834764831845f;
constexpr float THR = 8.f;
constexpr int NW = 8, QBLK = 32, KVBLK = 64, QB = NW * QBLK;
constexpr int SHM_V = KVBLK * D * 2, SHM_K = KVBLK * D * 2;
constexpr int LDS_ATT = 2 * SHM_V + 2 * SHM_K + NW * 64 * 4;
constexpr int LDS_C = LDS_ATT, LDS_WT = LDS_C + SEQ * 4;
template <class A, class Bt> struct same_t { static constexpr bool v = false; };
template <class A> struct same_t<A, A> { static constexpr bool v = true; };
#define KSWZ(row, colB) ((row) * 256 + ((colB) ^ (((row) & 7) << 4)))
#define SBAR() __builtin_amdgcn_sched_barrier(0)
__device__ __forceinline__ int v_st(int k, int c) { const int kk = (k & ~0xC) | ((k & 4) << 1) | ((k & 8) >> 1); return ((kk >> 3) * 4 + (c >> 5)) * 512 + ((kk & 7) * 32 + (c & 31)) * 2; }
__device__ __forceinline__ int v_rd_base(int lane) { return ((lane & 3) << 3) | (((lane >> 2) & 3) << 6) | (((lane >> 4) & 1) << 5) | (((lane >> 5) & 1) << 8); }
constexpr int v_rd_off(int d0, int ks, int half) { return d0 * 512 + ks * 4096 + half * 2048; }
__device__ __forceinline__ int crow(int r, int hi) { return (r & 3) + 8 * (r >> 2) + 4 * hi; }
__device__ __forceinline__ unsigned cvtpk(float lo, float hi) { unsigned r; asm volatile("v_cvt_pk_bf16_f32 %0, %1, %2" : "=v"(r) : "v"(lo), "v"(hi)); return r; }
__device__ __forceinline__ bf16x8 load8(const bf16* p) { return *reinterpret_cast<const bf16x8*>(p); }
__device__ __forceinline__ void mask_tile(f32x16& p0, f32x16& p1, int dq, unsigned W) {
    const float NEG = -__builtin_inff();
#pragma unroll
    for (int r = 0; r < 16; ++r) {
        const int c = (r & 3) + 8 * (r >> 2);
        if ((unsigned)(dq - c) >= W) p0[r] = NEG;
        if ((unsigned)(dq - c - 32) >= W) p1[r] = NEG;
    }
}
__device__ __forceinline__ void partialSM(f32x16& p0, f32x16& p1, float& m_reg, float& mn, float& alpha) {
    float pmax = p0[0]; for (int r = 1; r < 16; ++r) pmax = fmaxf(pmax, p0[r]); for (int r = 0; r < 16; ++r) pmax = fmaxf(pmax, p1[r]);
    { auto rr = __builtin_amdgcn_permlane32_swap(__float_as_uint(pmax), __float_as_uint(pmax), false, false);
      pmax = fmaxf(__uint_as_float(rr[0]), __uint_as_float(rr[1])); }
    constexpr float C2 = 1.4426950408889634f * SCALE;
    if (__builtin_expect(__all((pmax - m_reg) * SCALE <= THR), 1)) { mn = m_reg; alpha = 1.f; }
    else { mn = fmaxf(m_reg, pmax); alpha = __builtin_amdgcn_exp2f((m_reg - mn) * C2); m_reg = mn; }
    const float mnL = -mn * C2;
    for (int r = 0; r < 16; ++r) p0[r] = fmaf(p0[r], C2, mnL); for (int r = 0; r < 16; ++r) p1[r] = fmaf(p1[r], C2, mnL);
    for (int r = 0; r < 16; ++r) p0[r] = __builtin_amdgcn_exp2f(p0[r]);
}
__device__ __forceinline__ void finishSM(f32x16& p0, f32x16& p1, float alpha, float& l_reg, bf16x8& pa0, bf16x8& pa1, bf16x8& pa2, bf16x8& pa3) {
    for (int r = 0; r < 16; ++r) p1[r] = __builtin_amdgcn_exp2f(p1[r]);
    float ps = 0; for (int r = 0; r < 16; ++r) ps += p0[r]; for (int r = 0; r < 16; ++r) ps += p1[r];
    { auto rr = __builtin_amdgcn_permlane32_swap(__float_as_uint(ps), __float_as_uint(ps), false, false);
      ps = __uint_as_float(rr[0]) + __uint_as_float(rr[1]); }
    l_reg = l_reg * alpha + ps;
#define PK4(P, B_, OUT) do { unsigned a0 = cvtpk(P[B_+0], P[B_+1]), a1 = cvtpk(P[B_+2], P[B_+3]);                          \
        unsigned b0 = cvtpk(P[B_+4], P[B_+5]), b1 = cvtpk(P[B_+6], P[B_+7]);                                             \
        auto r0 = __builtin_amdgcn_permlane32_swap(a0, b0, false, false); auto r1 = __builtin_amdgcn_permlane32_swap(a1, b1, false, false); \
        u32x4 w = {r0[0], r1[0], r0[1], r1[1]}; OUT = *reinterpret_cast<bf16x8*>(&w); } while (0)
    PK4(p0, 0, pa0); PK4(p0, 8, pa1); PK4(p1, 0, pa2); PK4(p1, 8, pa3);
#undef PK4
}
template <int KB, bool FOX>
__device__ __forceinline__ void qkt(f32x16& p0, f32x16& p1, const char* K_lds, int r32, int hi, const bf16x8* qr, const float* cb, float cqs) {
    if constexpr (FOX) { const f32x4* cp = (const f32x4*)cb + hi;
#pragma unroll
        for (int g = 0; g < 4; ++g) { const f32x4 a = cp[2 * g], b = cp[8 + 2 * g];
#pragma unroll
            for (int j = 0; j < 4; ++j) { p0[4 * g + j] = cqs - a[j]; p1[4 * g + j] = cqs - b[j]; } } }
    else { p0 = f32x16{}; p1 = f32x16{}; }
    const char* kb[4];
#pragma unroll
    for (int dd = 0; dd < 4; ++dd) kb[dd] = K_lds + KB * SHM_K + KSWZ(r32, (dd * 16 + hi * 8) * 2);
#pragma unroll
    for (int d0 = 0; d0 < 8; ++d0) { const char* a = kb[d0 & 3] + (d0 >> 2) * 128;
        bf16x8 b0 = *reinterpret_cast<const bf16x8*>(a);
        bf16x8 b1 = *reinterpret_cast<const bf16x8*>(a + 32 * 256);
        p0 = __builtin_amdgcn_mfma_f32_32x32x16_bf16(b0, qr[d0], p0, 0, 0, 0);
        p1 = __builtin_amdgcn_mfma_f32_32x32x16_bf16(b1, qr[d0], p1, 0, 0, 0); }
}
template <int VB>
__device__ __forceinline__ void pv_tile(f32x16* o, int vb0, bf16x8 pa0, bf16x8 pa1, bf16x8 pa2, bf16x8 pa3) {
#define TRRD(dst, off) asm volatile("ds_read_b64_tr_b16 %0, %1 offset:%2" : "=&v"(dst) : "v"(vb0), "i"(off) : "memory")
#define PV_D0(d0) do { s16x4 l0, l1, l2, l3, h0, h1, h2, h3; constexpr int b_ = VB * SHM_V + v_rd_off(d0, 0, 0); \
        TRRD(l0, b_); TRRD(h0, b_ + 2048); TRRD(l1, b_ + 4096); TRRD(h1, b_ + 6144); TRRD(l2, b_ + 8192); TRRD(h2, b_ + 10240); TRRD(l3, b_ + 12288); TRRD(h3, b_ + 14336); \
        asm volatile("s_waitcnt lgkmcnt(0)" ::: "memory"); SBAR();   \
        o[d0] = __builtin_amdgcn_mfma_f32_32x32x16_bf16(pa0, (bf16x8){l0[0], l0[1], l0[2], l0[3], h0[0], h0[1], h0[2], h0[3]}, o[d0], 0, 0, 0);   \
        o[d0] = __builtin_amdgcn_mfma_f32_32x32x16_bf16(pa1, (bf16x8){l1[0], l1[1], l1[2], l1[3], h1[0], h1[1], h1[2], h1[3]}, o[d0], 0, 0, 0);   \
        o[d0] = __builtin_amdgcn_mfma_f32_32x32x16_bf16(pa2, (bf16x8){l2[0], l2[1], l2[2], l2[3], h2[0], h2[1], h2[2], h2[3]}, o[d0], 0, 0, 0);   \
        o[d0] = __builtin_amdgcn_mfma_f32_32x32x16_bf16(pa3, (bf16x8){l3[0], l3[1], l3[2], l3[3], h3[0], h3[1], h3[2], h3[3]}, o[d0], 0, 0, 0); } while (0)
    PV_D0(0); PV_D0(1); PV_D0(2); PV_D0(3);
#undef PV_D0
#undef TRRD
}
template <class TOut> struct BlockRef { const bf16* Q; const bf16* K; const bf16* V; TOut* O; int P0; int jlo; };
struct Seam { bf16x8 qr[8]; bf16x8 st_v0, st_v1, st_k0, st_k1; };
#define ROWB(p, k0, rr) ((const bf16*)((const char*)(p) + ((size_t)((k0) + (rr)) * KP * 2) + loff))
#define VMW() asm volatile("s_waitcnt vmcnt(0)" ::: "memory")
#define VMWN(n) asm volatile("s_waitcnt vmcnt(%0)" :: "i"(n) : "memory")
#define SLOAD_H(Kp, Vp, k0) do { S.st_v0 = load8(ROWB(Vp, k0, 0)); S.st_v1 = load8(ROWB(Vp, k0, 32));              \
                         S.st_k0 = load8(ROWB(Kp, k0, 0)); S.st_k1 = load8(ROWB(Kp, k0, 32)); } while (0)
#define SWRITE_HK(bf) do { *(bf16x8*)(K_lds + (bf) * SHM_K + kws) = S.st_k0; *(bf16x8*)(K_lds + (bf) * SHM_K + kws + 32 * 256) = S.st_k1; } while (0)
#define SWRITE_HV(bf) do { *(bf16x8*)(V_lds + (bf) * SHM_V + vst0) = S.st_v0; *(bf16x8*)(V_lds + (bf) * SHM_V + vst1) = S.st_v1; } while (0)
#define SWRITE_H(bf) do { SWRITE_HV(bf); SWRITE_HK(bf); } while (0)
template <class TOut>
__device__ __forceinline__ void prime(const BlockRef<TOut>& cur, char* lds, Seam& S) {
    const int tid = opaque_tid(), wid = __builtin_amdgcn_readfirstlane(tid >> 6), lane = tid & 63, r32 = lane & 31, hi = lane >> 5;
    const int sr = tid >> 4, sc = (tid & 15) * 8, kws = KSWZ(sr, sc * 2); char* K_lds = lds + 2 * SHM_V;
    const unsigned loff = (unsigned)(sr * KP + sc) * 2u, qoff = (unsigned)(r32 * KP + hi * 8) * 2u;
    { const char* qb_ = (const char*)cur.Q + (size_t)(wid * QBLK) * KP * 2;
#pragma unroll
    for (int d0 = 0; d0 < 8; ++d0) S.qr[d0] = load8((const bf16*)(qb_ + d0 * 32 + qoff)); }
    SLOAD_H(cur.K, cur.V, cur.jlo * KVBLK); VMW(); SWRITE_HK(0);
    __syncthreads();
}
template <class TOut, bool FOX>
__device__ __forceinline__ void block(const BlockRef<TOut>& cur, const BlockRef<TOut>& nxt, char* lds, Seam& S) {
    const int tid = opaque_tid(), wid = __builtin_amdgcn_readfirstlane(tid >> 6), lane = tid & 63, r32 = lane & 31, hi = lane >> 5;
    constexpr int W = SEQ;
    const int j_lo = cur.jlo; const int NT = (cur.P0 + QB - 1) / KVBLK + 1 - j_lo;
    const int qlo = cur.P0 + wid * QBLK, qm = qlo + r32 - 4 * hi;
    char* V_lds = lds; char* K_lds = lds + 2 * SHM_V;
    float* ws = (float*)(lds + 2 * SHM_V + 2 * SHM_K) + wid * 64; float* li_l = ws, * al_l = ws + 32;
    const float* c_l = (const float*)(lds + LDS_C);
    float cqs = 0.f; if constexpr (FOX) cqs = c_l[qlo + r32];
    float m_reg = -1e30f, l_reg = 0; f32x16 o[4] = {};
    const int sr = tid >> 4, sc = (tid & 15) * 8, vst0 = v_st(sr, sc), vst1 = v_st(32 + sr, sc), kws = KSWZ(sr, sc * 2);
    const unsigned loff = (unsigned)(sr * KP + sc) * 2u, qoff = (unsigned)(r32 * KP + hi * 8) * 2u;
    const int vb0 = (int)(uintptr_t)V_lds + v_rd_base(lane);
    const bf16* Kh = cur.K; const bf16* Vh = cur.V;
#define RESC(a) do { if (__any((a) < 1.f)) { if (hi == 0) al_l[r32] = (a); asm volatile("s_waitcnt lgkmcnt(0)" ::: "memory");              \
                     for (int d_ = 0; d_ < 4; ++d_) for (int r = 0; r < 16; ++r) o[d_][r] *= al_l[crow(r, hi)]; } } while (0)
#define KBASE(t) ((j_lo + (t)) * KVBLK)
#define MASKT(P0_, P1_, t) do { const int kb_ = KBASE(t); if (kb_ + KVBLK - 1 > qlo) mask_tile(P0_, P1_, qm - kb_, (unsigned)W); } while (0)
    constexpr int NQL = 8;
#define SEAM_K0() do { VMWN(NQL); SWRITE_HK(0); SBAR(); } while (0)
    f32x16 pA0, pA1, pB0, pB1; float mnA, mnB, alA, alB; bf16x8 pa0, pa1, pa2, pa3;
    SWRITE_HV(0); SBAR();
    if (NT > 1) { SLOAD_H(Kh, Vh, KBASE(1)); }
    SBAR(); qkt<0, FOX>(pA0, pA1, K_lds, r32, hi, S.qr, c_l + KBASE(0), cqs);
    MASKT(pA0, pA1, 0); partialSM(pA0, pA1, m_reg, mnA, alA);
    if (NT > 1) { VMW(); SWRITE_H(1); }
    __syncthreads();
#define HALF_STEP(PX0, PX1, mnX, alX, PY0, PY1, alY, t, KB, VB, SB) do {                                                      \
        SBAR(); qkt<KB, FOX>(PX0, PX1, K_lds, r32, hi, S.qr, c_l + KBASE(t), cqs);                                          \
        finishSM(PY0, PY1, alY, l_reg, pa0, pa1, pa2, pa3); SBAR();                                                           \
        if ((t) + 1 < NT) { SLOAD_H(Kh, Vh, KBASE((t) + 1)); SBAR(); }                                                        \
        pv_tile<VB>(o, vb0, pa0, pa1, pa2, pa3); MASKT(PX0, PX1, (t)); partialSM(PX0, PX1, m_reg, mnX, alX);                \
        __syncthreads();                                                                                                      \
        if ((t) + 1 < NT) { VMW(); SWRITE_H(SB); }                                                                            \
        RESC(alX); __syncthreads(); } while (0)
    for (int t = 1; t + 1 < NT; t += 2) {
        HALF_STEP(pB0, pB1, mnB, alB, pA0, pA1, alA, t, 1, 0, 0);
        HALF_STEP(pA0, pA1, mnA, alA, pB0, pB1, alB, t + 1, 0, 1, 1);
    }
    const bool even = (NT & 1) == 0;
    if (even) { SBAR(); qkt<1, FOX>(pB0, pB1, K_lds, r32, hi, S.qr, c_l + KBASE(NT - 1), cqs); SBAR(); }
    SLOAD_H(nxt.K, nxt.V, nxt.jlo * KVBLK); SBAR();
    { const char* qb_ = (const char*)nxt.Q + (size_t)(wid * QBLK) * KP * 2;
#pragma unroll
    for (int d0 = 0; d0 < 8; ++d0) S.qr[d0] = load8((const bf16*)(qb_ + d0 * 32 + qoff)); }
    SBAR();
    finishSM(pA0, pA1, alA, l_reg, pa0, pa1, pa2, pa3); SBAR();
    pv_tile<0>(o, vb0, pa0, pa1, pa2, pa3);
    if (even) { MASKT(pB0, pB1, NT - 1); partialSM(pB0, pB1, m_reg, mnB, alB); __syncthreads(); RESC(alB);
        finishSM(pB0, pB1, alB, l_reg, pa0, pa1, pa2, pa3); SBAR(); pv_tile<1>(o, vb0, pa0, pa1, pa2, pa3); }
    SBAR(); SEAM_K0();
    if (hi == 0) li_l[r32] = l_reg; asm volatile("s_waitcnt lgkmcnt(0)" ::: "memory");
    float rli[16];
#pragma unroll
    for (int r = 0; r < 16; ++r) rli[r] = __builtin_amdgcn_rcpf(li_l[crow(r, hi)]);
    char* Ow = (char*)(cur.O + (size_t)(wid * QBLK) * OP);
    const unsigned ooff = (unsigned)(4 * hi * OP + r32) * (unsigned)sizeof(TOut);
#pragma unroll
    for (int r = 0; r < 16; ++r) { char* Or = Ow + (size_t)((r & 3) + 8 * (r >> 2)) * OP * sizeof(TOut);
#pragma unroll
        for (int d0 = 0; d0 < 4; ++d0) { const float v = o[d0][r] * rli[r];
            if constexpr (same_t<TOut, float>::v) { *(float*)(Or + d0 * 32 * 4 + ooff) = v; }
            else { const float vn = __shfl_xor(v, 1);
                   if ((r32 & 1) == 0) *(unsigned*)(Or + d0 * 32 * 2 + ooff) = cvtpk(v, vn); } } }
    __syncthreads();
#undef RESC
#undef KBASE
#undef MASKT
#undef SEAM_K0
#undef HALF_STEP
}
#undef ROWB
#undef VMW
#undef VMWN
#undef SLOAD_H
#undef SWRITE_HK
#undef SWRITE_HV
#undef SWRITE_H
#undef KSWZ
#undef SBAR
__device__ __forceinline__ void fox_load_c(const float* logf_bh, char* lds, int) {
    const int tid = opaque_tid(), lane = tid & 63, wid = tid >> 6;
    float* c_l = (float*)(lds + LDS_C); float* wt = (float*)(lds + LDS_WT);
    f32x4 v[4]; const f32x4* src = (const f32x4*)(logf_bh + 16 * tid);
#pragma unroll
    for (int i = 0; i < 4; ++i) v[i] = src[i];
    float run = 0.f;
#pragma unroll
    for (int i = 0; i < 4; ++i)
#pragma unroll
        for (int j = 0; j < 4; ++j) { run += v[i][j]; v[i][j] = run; }
    float inc = run;
#pragma unroll
    for (int o = 1; o < 64; o <<= 1) { const float t = __shfl_up(inc, o); if (lane >= o) inc += t; }
    if (lane == 63) wt[wid] = inc;
    __syncthreads();
    float base = inc - run;
    for (int w = 0; w < wid; ++w) base += wt[w];
    const float RS = 11.313708498984761f;
#pragma unroll
    for (int i = 0; i < 4; ++i) { f32x4 o;
#pragma unroll
        for (int j = 0; j < 4; ++j) o[j] = (v[i][j] + base) * RS;
        *(f32x4*)(c_l + 16 * tid + 4 * i) = o; }
}
__device__ __forceinline__ int fox_jlo(const char* lds, int P0, float thr) {
    const float* c_l = (const float*)(lds + LDS_C); const float cq = c_l[P0];
    int lo = 0, hi = P0 / KVBLK;
    while (lo < hi) { const int mid = (lo + hi) >> 1; const bool prune = (cq - c_l[mid * KVBLK + KVBLK - 1]) < -thr; if (prune) lo = mid + 1; else hi = mid; }
    return __builtin_amdgcn_readfirstlane(lo);
}
}

#define XB_TMO      128
#define XB_XCNT(j)  (256  + 64 * (j))
#define XB_XSUB(j)  (1280 + 64 * (j))
#define XB_XGEN(j)  (2304 + 64 * (j))
#define XB_TOP      3328
#define XB_TOPGEN   3392
#define XCD_BAR_WORDS 3456
#define XB_SPIN_CAP (1u << 18)
__device__ __forceinline__ unsigned xb_ld(unsigned* p)              { return __hip_atomic_load(p, __ATOMIC_RELAXED, __HIP_MEMORY_SCOPE_AGENT); }
__device__ __forceinline__ unsigned xb_add(unsigned* p, unsigned v) { return __hip_atomic_fetch_add(p, v, __ATOMIC_RELAXED, __HIP_MEMORY_SCOPE_AGENT); }
__device__ __forceinline__ unsigned xb_xcc_id() { return (unsigned)__builtin_amdgcn_s_getreg((3 << 11) | 20) & 0xFu; }
#define XB_SPIN(cond, bar) do { unsigned _sp = 0; while (cond) { __builtin_amdgcn_s_sleep(1); \
    if ((++_sp & 255u) == 0u) { if (xb_ld(&(bar)[XB_TMO])) break; if (_sp > XB_SPIN_CAP) { atomicAdd(&(bar)[XB_TMO], 1u); break; } } } } while (0)
struct XcdBarrier { unsigned* bar; unsigned x; volatile LAS unsigned* st; };
__device__ __forceinline__ XcdBarrier xcd_barrier_post(unsigned* bar, volatile LAS unsigned* st) {
    XcdBarrier b; b.bar = bar; b.x = xb_xcc_id(); b.st = st;
    if (threadIdx.x == 0) (void)xb_add(&bar[XB_XCNT(b.x)], 1u);
    return b;
}
__device__ __forceinline__ void xcd_barrier_complete(unsigned* bar, unsigned x, unsigned& nloc, unsigned& nx) {
    const unsigned G = gridDim.x * gridDim.y * gridDim.z;
    unsigned sum, cnt, mine, sp = 0u;
    for (;;) {
        sum = 0u; cnt = 0u; mine = 0u;
#pragma unroll
        for (unsigned j = 0; j < 16; ++j) { const unsigned c = xb_ld(&bar[XB_XCNT(j)]); sum += c; cnt += (c > 0u) ? 1u : 0u; mine = (j == x) ? c : mine; }
        if (sum == G) break;
        __builtin_amdgcn_s_sleep(1);
        if ((++sp & 255u) == 0u) { if (xb_ld(&bar[XB_TMO])) break; if (sp > XB_SPIN_CAP) { atomicAdd(&bar[XB_TMO], 1u); break; } }
    }
    nloc = mine > 0u ? mine : 1u; nx = cnt > 0u ? cnt : 1u;
}
__device__ __forceinline__ void xcd_barrier(const XcdBarrier& b) {
    asm volatile("s_waitcnt vmcnt(0)" ::: "memory");
    __syncthreads();
    if (threadIdx.x == 0) {
        unsigned* bar = b.bar;
        __builtin_amdgcn_s_waitcnt(0);
        unsigned nloc = b.st[0], nx = b.st[1];
        if (nloc == 0u) { xcd_barrier_complete(bar, b.x, nloc, nx); b.st[0] = nloc; b.st[1] = nx; }
        const unsigned old = xb_add(&bar[XB_XSUB(b.x)], 1u);
        const unsigned gen = old / nloc;
        if (old + 1u == (gen + 1u) * nloc) {
            __builtin_amdgcn_fence(__ATOMIC_RELEASE, "agent");
            asm volatile("s_waitcnt vmcnt(0)" ::: "memory");
            const unsigned og = xb_add(&bar[XB_TOP], 1u);
            const unsigned tg = og / nx;
            if (og + 1u == (tg + 1u) * nx) xb_add(&bar[XB_TOPGEN], 1u);
            else XB_SPIN(xb_ld(&bar[XB_TOPGEN]) == tg, bar);
            __builtin_amdgcn_fence(__ATOMIC_ACQUIRE, "agent");
            xb_add(&bar[XB_XGEN(b.x)], 1u);
            asm volatile("s_waitcnt vmcnt(0)" ::: "memory");
        } else {
            XB_SPIN(xb_ld(&bar[XB_XGEN(b.x)]) == gen, bar);
            __builtin_amdgcn_fence(__ATOMIC_ACQUIRE, "agent");
            asm volatile("s_waitcnt vmcnt(0)" ::: "memory");
        }
    }
    __syncthreads();
}

struct Args { const float* in[17]; float* out; unsigned char* ws; int ph_lo, ph_hi; };
enum { I_X = 0, I_WIN, I_BF, I_DLAM, I_SUBG, I_WO, I_LN1G, I_LN1B, I_WRG, I_BRG, I_WRE, I_BRE, I_WG, I_WU, I_WDN, I_LN2G, I_LN2B };

__device__ __forceinline__ void transpose_item(const float* src, int ldw, bf16_t* dst, int ldd, LAS float* scr, int lane) {
#pragma unroll 8
    for (int i = 0; i < 32; ++i) { const int kk = 2 * i + (lane >> 5); scr[kk * 33 + (lane & 31)] = __builtin_nontemporal_load(src + (size_t)kk * ldw + (lane & 31)); }
    LDS_WAIT(); asm volatile("" ::: "memory");
    const int c = lane & 7;
#pragma unroll
    for (int j = 0; j < 4; ++j) { const int n = (lane >> 3) + 8 * j; const LAS float* s = scr + (8 * c) * 33 + n;
        u32x4 o; o.x = pk2(s[0 * 33], s[1 * 33]); o.y = pk2(s[2 * 33], s[3 * 33]); o.z = pk2(s[4 * 33], s[5 * 33]); o.w = pk2(s[6 * 33], s[7 * 33]);
        *(GAS u32x4*)(dst + (size_t)n * ldd + 8 * c) = o; }
    LDS_WAIT(); asm volatile("" ::: "memory");
}

template <int NT>
__device__ __forceinline__ void skinny_logits(const bf16_t* X, const bf16_t* Wt, LAS float* part, LAS float* logits, int tid) {
    const int lane = tid & 63, wid = __builtin_amdgcn_readfirstlane(tid >> 6), r = lane & 15, kq = lane >> 4;
    f32x4 acc[4][NT];
#pragma unroll
    for (int mt = 0; mt < 4; ++mt)
#pragma unroll
        for (int nt = 0; nt < NT; ++nt) acc[mt][nt] = (f32x4){0.f, 0.f, 0.f, 0.f};
    const bf16_t* ap = X + (size_t)r * DM + wid * 256 + kq * 8;
    const bf16_t* bp = Wt + (size_t)r * DM + wid * 256 + kq * 8;
#pragma unroll 2
    for (int ks = 0; ks < 8; ++ks) {
        bf16x8 a[4], b[NT];
#pragma unroll
        for (int mt = 0; mt < 4; ++mt) a[mt] = *(const GAS bf16x8*)(ap + (size_t)mt * 16 * DM + ks * 32);
#pragma unroll
        for (int nt = 0; nt < NT; ++nt) b[nt] = *(const GAS bf16x8*)(bp + (size_t)nt * 16 * DM + ks * 32);
#pragma unroll
        for (int mt = 0; mt < 4; ++mt)
#pragma unroll
            for (int nt = 0; nt < NT; ++nt) acc[mt][nt] = __builtin_amdgcn_mfma_f32_16x16x32_bf16(a[mt], b[nt], acc[mt][nt], 0, 0, 0);
    }
    constexpr int LW = 16 * NT;
#pragma unroll
    for (int mt = 0; mt < 4; ++mt)
#pragma unroll
        for (int nt = 0; nt < NT; ++nt)
#pragma unroll
            for (int g = 0; g < 4; ++g) part[(wid * 64 + mt * 16 + 4 * kq + g) * LW + nt * 16 + r] = acc[mt][nt][g];
    __syncthreads();
    for (int o = tid; o < 64 * LW; o += 512) { float s = 0.f;
#pragma unroll
        for (int w = 0; w < 8; ++w) s += part[w * 64 * LW + o];
        logits[o] = s; }
    __syncthreads();
}

__device__ __forceinline__ att::BlockRef<att::bf16> fox_ref(int L, int pass, const bf16_t* FQ_, const bf16_t* FK_, const bf16_t* FV_, bf16_t* MRG_) {
    const int bh = L >> 4, x = L & 15, qb = pass ? 31 - x : x, b = bh >> 3, h = bh & 7;
    const size_t hb = (size_t)bh * SEQ * HD; att::BlockRef<att::bf16> r;
    r.Q = (const att::bf16*)FQ_ + hb + (size_t)qb * 256 * HD; r.K = (const att::bf16*)FK_ + hb; r.V = (const att::bf16*)FV_ + hb;
    r.O = (att::bf16*)MRG_ + ((size_t)b * SEQ + (size_t)qb * 256) * att::OP + h * HD; r.P0 = qb * 256; r.jlo = 0; return r;
}
template <class TOut>
__device__ __forceinline__ att::BlockRef<TOut> dif_ref(int L, int pass, const bf16_t* DQ_, const bf16_t* DK_, const bf16_t* DV_, TOut* OD_) {
    const int vh = L >> 4, x = L & 15, qb = pass ? x : 31 - x, v = vh & 1, j = (vh >> 1) & 1, h = (vh >> 2) & 3, b = vh >> 4;
    const size_t hq = (size_t)(b * 8 + 2 * h + j) * SEQ * HD, hv = (size_t)(b * 8 + 2 * h + v) * SEQ * HD; att::BlockRef<TOut> r;
    r.Q = (const att::bf16*)DQ_ + hq + (size_t)qb * 256 * HD; r.K = (const att::bf16*)DK_ + hq; r.V = (const att::bf16*)DV_ + hv;
    r.O = OD_ + ((size_t)b * SEQ + (size_t)qb * 256) * att::OP + h * 512 + j * 256 + v * HD; r.P0 = qb * 256; r.jlo = 0; return r;
}

__global__ void __launch_bounds__(512, 2) trunk_fwd(Args args) {
    extern __shared__ __attribute__((aligned(16))) unsigned char lds_raw[];
    LAS unsigned char* lds = (LAS unsigned char*)lds_raw;
    const int G = gridDim.x, bx = blockIdx.x;
    const int vcu = (G % 8 == 0) ? (bx % 8) * (G / 8) + bx / 8 : bx;
    volatile LAS unsigned* MISC = (volatile LAS unsigned*)(lds + MISC_OFF);
    if (threadIdx.x < 32) MISC[threadIdx.x] = 0u;
    __syncthreads();
#define PHASE_LOCALS const int tid = opaque_tid(), lane = tid & 63, wave = __builtin_amdgcn_readfirstlane(tid >> 6); unsigned char* ws = opaque_ptr(args.ws); unsigned* ctl = (unsigned*)(ws + WS_CTL); (void)lane; (void)wave; (void)ctl;
    const int lo = args.ph_lo, hi = args.ph_hi;
    const bool use_bar = (hi - lo) > 1;
    XcdBarrier bar; bar.bar = (unsigned*)(args.ws + WS_CTL) + CW_BAR; bar.x = 0; bar.st = nullptr;
    if (use_bar) bar = xcd_barrier_post((unsigned*)(args.ws + WS_CTL) + CW_BAR, MISC + 8);
#ifndef PROBE_DUP
#define PROBE_DUP -1
#endif
#define REPS(k) for (int rep_ = 0; rep_ < ((PROBE_DUP) == (k) ? 2 : 1); ++rep_)
#ifndef PH_MASK
#define PH_MASK 0x1ff
#endif
#define PHK(k) ((k) == 0 ? 0 : (((k) - 1) % 8) + 1)
#define IN(k) (((PH_MASK >> PHK(k)) & 1) && lo <= (k) && (k) < hi)
#define BOTH(k) (IN(k) && IN((k) + 1))
#define GRID_BAR() do { xcd_barrier(bar); } while (0)

#define WIN_T ((bf16_t*)(ws + WS_WIN))
#define WO_T ((bf16_t*)(ws + WS_WO))
#define WGU_T ((bf16_t*)(ws + WS_WGU))
#define WD_T ((bf16_t*)(ws + WS_WD))
#define WF_T ((bf16_t*)(ws + WS_WF))
#define WR_T ((bf16_t*)(ws + WS_WR))
#define COS ((float*)(ws + WS_COS))
#define SIN ((float*)(ws + WS_SIN))
#define LOGF ((float*)(ws + WS_LOGF))
#define TOK ((unsigned*)(ws + WS_TOK))
#define LIST ((int*)(ws + WS_LIST))
#define PB ((float*)(ws + WS_P))
#define QBUF ((float*)(ws + WS_Q))
#define XB ((bf16_t*)(ws + WS_XB))
#define PROJ ((bf16_t*)(ws + WS_PROJ))
#define MRG ((bf16_t*)(ws + WS_MRG))
#define OD ((att::bf16*)(ws + WS_OD))
#define HID ((bf16_t*)(ws + WS_HID))
#define YS ((bf16_t*)(ws + WS_YS))
    constexpr size_t PSTR = (size_t)M * 1024;
#define FQ (PROJ)
#define FK (PROJ + PSTR)
#define FV (PROJ + 2 * PSTR)
#define DQ (PROJ + 3 * PSTR)
#define DK (PROJ + 4 * PSTR)
#define DV (PROJ + 5 * PSTR)
    LAS int* utab = (LAS int*)(lds + T_UTAB); LAS unsigned* rowtab = (LAS unsigned*)(lds + T_ROWTAB);
#define x_in (args.in[I_X])
#define FILL_STATIC(Mr, Nc) do { if (tid < 64) { pg8::StaticOrder SO; SO.init(Mr, Nc, G, bx); pg8::Unit u_; u_.pm = 0; u_.pn = 0; const bool ok_ = (tid < 8) && SO.next(tid, u_); \
        if (tid < 8) { utab[2 * tid] = u_.pm; utab[2 * tid + 1] = u_.pn; } const unsigned long long m_ = __ballot(ok_); if (tid == 0) ((LAS int*)(lds + T_MISC))[1] = __popcll(m_); } __syncthreads(); } while (0)
#define FILL_GROUPED(U_, sh_) do { if (tid < 64) { pg8::Unit u_; u_.pm = 0; u_.pn = 0; const bool ok_ = (tid < 8) && pg8::grouped_unit(U_, bx % 8, bx / 8, G / 8, sh_, chunk_e, tid, u_); \
        if (tid < 8) { utab[2 * tid] = u_.pm; utab[2 * tid + 1] = u_.pn; } const unsigned long long m_ = __ballot(ok_); if (tid == 0) tmisc[1] = __popcll(m_); } __syncthreads(); } while (0)
    if (IN(0)) REPS(8) {
        PHASE_LOCALS
        LAS float* scr = (LAS float*)(lds + wave * 16384);
        const int gw = vcu * 8 + wave, NGW = G * 8;
        constexpr int I_A = DEPTH * 32 * 192, I_B = DEPTH * 32 * 64, I_C = DEPTH * NE * 32 * 16, I_E = DEPTH * NE * 8 * 64;
        constexpr int NITEMS = I_A + I_B + 2 * I_C + I_E;
        for (int it = gw; it < NITEMS; it += NGW) {
            int r = it;
            if (r < I_A) { const int l = r / (32 * 192), rem = r % (32 * 192), kb = rem / 192, nb = rem % 192; const int n0 = 32 * nb, sc0 = n0 + (n0 >= 3072 ? 8 : 0);
                transpose_item(args.in[I_WIN] + (size_t)l * DM * INW + (size_t)(64 * kb) * INW + sc0, INW, WIN_T + (size_t)l * NPROJ * DM + (size_t)n0 * DM + 64 * kb, DM, scr, lane); continue; }
            r -= I_A;
            if (r < I_B) { const int l = r / (32 * 64), rem = r % (32 * 64), kb = rem / 64, nb = rem % 64;
                transpose_item(args.in[I_WO] + (size_t)l * DM * DM + (size_t)(64 * kb) * DM + 32 * nb, DM, WO_T + (size_t)l * DM * DM + (size_t)(32 * nb) * DM + 64 * kb, DM, scr, lane); continue; }
            r -= I_B;
            if (r < 2 * I_C) { const int up = r >= I_C ? 1 : 0; if (up) r -= I_C; const int le = r / 512, rem = r % 512, kb = rem / 16, nb = rem % 16;
                const float* src = (up ? args.in[I_WU] : args.in[I_WG]) + (size_t)le * DM * DE + (size_t)(64 * kb) * DE + 32 * nb;
                const int drow = 256 * (nb >> 2) + 32 * (nb & 3) + 128 * up;
                transpose_item(src, DE, WGU_T + (size_t)le * 1024 * DM + (size_t)drow * DM + 64 * kb, DM, scr, lane); continue; }
            r -= 2 * I_C;
            { const int le = r / 512, rem = r % 512, kb = rem / 64, nb = rem % 64;
                transpose_item(args.in[I_WDN] + (size_t)le * DE * DM + (size_t)(64 * kb) * DM + 32 * nb, DM, WD_T + (size_t)le * DM * DE + (size_t)(32 * nb) * DE + 64 * kb, DE, scr, lane); }
        }
        const int gt = vcu * 512 + tid, NGT = G * 512;
        for (int idx = gt; idx < DEPTH * 16 * DM; idx += NGT) { const int l = idx / (16 * DM), rem = idx % (16 * DM), n = rem / DM, k = rem % DM;
            const float v = (n < 8) ? args.in[I_WIN][(size_t)l * DM * INW + (size_t)k * INW + 3072 + n] : 0.f; WF_T[idx] = (bf16_t)f2bf(v); }
        for (int idx = gt; idx < DEPTH * 48 * DM; idx += NGT) { const int l = idx / (48 * DM), rem = idx % (48 * DM), n = rem / DM, k = rem % DM;
            float v = 0.f; if (n < 4) v = args.in[I_WRG][(size_t)l * DM * 4 + (size_t)k * 4 + n]; else if (n < 36) v = args.in[I_WRE][(size_t)l * DM * 32 + (size_t)k * 32 + (n - 4)];
            WR_T[idx] = (bf16_t)f2bf(v); }
        for (int idx = gt; idx < SEQ * 16; idx += NGT) { const int pos = idx >> 4, i = idx & 15;
            const double inv = pow(500000.0, -(double)i * (1.0 / 16.0));
            const double ang = (double)pos * inv; COS[idx] = (float)cos(ang); SIN[idx] = (float)sin(ang); }
        for (int idx = gt; idx < M * DM / 8; idx += NGT) { const f32x4 a = *(const GAS f32x4*)(x_in + (size_t)idx * 8), b = *(const GAS f32x4*)(x_in + (size_t)idx * 8 + 4);
            u32x4 w; w.x = pk2(a[0], a[1]); w.y = pk2(a[2], a[3]); w.z = pk2(b[0], b[1]); w.w = pk2(b[2], b[3]); *(GAS u32x4*)(XB + (size_t)idx * 8) = w; }
        if (BOTH(0) || rep_ == 0 && (PROBE_DUP) == 8) GRID_BAR();
    }

    for (int l = 0; l < DEPTH; ++l) {
        const int pb = 1 + 8 * l;
        const float lam_init = 0.8f - 0.6f * expf(-0.3f * (float)l);
#define Pin ((l == 0) ? x_in : (const float*)PB)
#define Pout ((l == DEPTH - 1) ? args.out : PB)
#define cnt (ctl + CW_CNT + l * 32 * 16)

        if (IN(pb + 0)) REPS(0) {
            PHASE_LOCALS
            LAS float* part = (LAS float*)(lds + 16384); LAS float* logits = (LAS float*)(lds + 114688);
            for (int tile = bx; tile < M / 64; tile += G) {
                skinny_logits<1>(XB + (size_t)tile * 64 * DM, WF_T + (size_t)l * 16 * DM, part, logits, tid);
                if (tid < 64) { const int token = tile * 64 + tid, b = token / SEQ, pos = token % SEQ;
#pragma unroll
                    for (int h = 0; h < 8; ++h) { const float z = logits[tid * 16 + h] + args.in[I_BF][l * 8 + h];
                        const float lf = fminf(z, 0.f) - log1pf(__expf(-fabsf(z)));
                        LOGF[(size_t)(b * 8 + h) * SEQ + pos] = lf; } }
                __syncthreads();
            }
            FILL_STATIC(M, NPROJ);
            pg8::Gemm g{XB, WIN_T + (size_t)l * NPROJ * DM, DM}; pg8::TabOrder S{((LAS int*)(lds + T_MISC))[1], utab, rowtab};
            pg8::EpiInProj E{ws, l};
            pg8::gemm_phase<pg8::EpiInProj, pg8::TabOrder, false>(lds, g, S, E);
            if (BOTH(pb + 0) || (rep_ == 0 && (PROBE_DUP) == 0)) GRID_BAR();
        }

        if (IN(pb + 1)) REPS(1) {
            PHASE_LOCALS
            char* alds = (char*)lds_raw;
#ifndef NO_DIF
            for (int rd_ = 0; rd_ < ((PROBE_DUP) == 11 ? 2 : 1); ++rd_) {
                typedef att::BlockRef<att::bf16> BR;
                constexpr int TOTAL = BATCH * DIFH * 4 * 16;
                int L = vcu;
                if (L < TOTAL) {
                    int pass = 0; BR cur = dif_ref<att::bf16>(L, 0, DQ, DK, DV, OD); att::Seam S; att::prime<att::bf16>(cur, alds, S);
                    for (;;) {
                        const bool more_pass = pass == 0, more_item = L + G < TOTAL, last = !more_pass && !more_item;
                        const int passn = more_pass ? 1 : 0, Ln = more_pass ? L : (more_item ? L + G : L);
                        const BR nxt = last ? cur : dif_ref<att::bf16>(Ln, passn, DQ, DK, DV, OD);
                        att::block<att::bf16, false>(cur, nxt, alds, S);
                        if (last) break;
                        cur = nxt; pass = passn; L = Ln;
                    }
                }
            }
#endif
#ifndef NO_FOX
            for (int rf_ = 0; rf_ < ((PROBE_DUP) == 12 ? 2 : 1); ++rf_) {
                typedef att::BlockRef<att::bf16> BR;
                constexpr int TOTAL = BATCH * FOXH * 16;
                LAS int* tm = (LAS int*)(lds + T_MISC);
                if (tid < 16) { const float key = args.in[I_BF][l * 8 + (tid & 7)]; int rank = 0;
#pragma unroll
                    for (int o = 0; o < 16; ++o) { const float ko = args.in[I_BF][l * 8 + (o & 7)]; rank += ((ko > key) || (ko == key && o < tid)) ? 1 : 0; }
                    tm[4 + rank] = tid; }
                __syncthreads();
                for (;;) {
                    if (tid == 0) tm[2] = (int)__hip_atomic_fetch_add(ctl + CW_QHEAD + l * 16 + rep_ + 2 * rf_, 1u, RLX_AGENT);
                    __syncthreads();
                    const int it = __builtin_amdgcn_readfirstlane(tm[2]);
                    if (it >= TOTAL) break;
                    const int bh = __builtin_amdgcn_readfirstlane(tm[4 + (it >> 4)]); const int L = bh * 16 + (it & 15);
                    att::fox_load_c(LOGF + (size_t)bh * SEQ, alds, tid); __syncthreads();
                    float smax = 0.f;
#pragma unroll
                    for (int g4 = 0; g4 < 4; ++g4) { const float q2 = __uint_as_float(__hip_atomic_load(ctl + CW_NMAX + l * 256 + (bh * 4 + g4) * 2, RLX_AGENT)), k2 = __uint_as_float(__hip_atomic_load(ctl + CW_NMAX + l * 256 + (bh * 4 + g4) * 2 + 1, RLX_AGENT)); smax += sqrtf(q2 * k2); }
                    const float thr = (FOX_PRUNE_T + 2.f * (smax * att::SCALE * 1.02f)) * 11.313708498984761f;
                    BR b0 = fox_ref(L, 0, FQ, FK, FV, MRG), b1 = fox_ref(L, 1, FQ, FK, FV, MRG);
                    b0.jlo = att::fox_jlo(alds, b0.P0, thr); b1.jlo = att::fox_jlo(alds, b1.P0, thr);
                    att::Seam S; att::prime<att::bf16>(b0, alds, S);
                    att::block<att::bf16, true>(b0, b1, alds, S);
                    att::block<att::bf16, true>(b1, b1, alds, S);
                }
            }
#endif
            if (BOTH(pb + 1) || (rep_ == 0 && (PROBE_DUP) == 1)) GRID_BAR();
        }

        if (IN(pb + 2)) REPS(2) {
            PHASE_LOCALS
            const float* lv = args.in[I_DLAM] + l * 4 * HD;
            float d1 = lv[lane] * lv[HD + lane] + lv[64 + lane] * lv[HD + 64 + lane], d2 = lv[2 * HD + lane] * lv[3 * HD + lane] + lv[2 * HD + 64 + lane] * lv[3 * HD + 64 + lane];
            d1 = wave_sum(d1); d2 = wave_sum(d2);
            const float lam = __expf(d1) - __expf(d2) + lam_init;
            const f32x4 gsub = *(const f32x4*)(args.in[I_SUBG] + l * 256 + 4 * lane);
            const float osc = 1.f - lam_init;
            const int gw = vcu * 8 + wave, NGW = G * 8;
            for (int task = gw; task < M * DIFH; task += NGW) { const int row = task >> 2, h = task & 3;
                const bf16_t* src = (const bf16_t*)OD + (size_t)row * 2048 + h * 512 + 4 * lane;
                const u32x2 r1 = *(const GAS u32x2*)src, r2 = *(const GAS u32x2*)(src + 256);
                const f32x4 o1 = (f32x4){bf_lo(r1.x), bf_hi(r1.x), bf_lo(r1.y), bf_hi(r1.y)}, o2 = (f32x4){bf_lo(r2.x), bf_hi(r2.x), bf_lo(r2.y), bf_hi(r2.y)};
                const f32x4 d = o1 - o2 * lam;
                const float ss = wave_sum((d[0] * d[0] + d[1] * d[1]) + (d[2] * d[2] + d[3] * d[3]));
                const float rs = (1.0f / sqrtf(ss * (1.f / 256.f) + RMS_EPS)) * osc;
                const f32x4 y = d * gsub * rs;
                u32x2 w; w.x = cvt_pk_bf16(y[0], y[1]); w.y = cvt_pk_bf16(y[2], y[3]);
                *(GAS u32x2*)(MRG + (size_t)row * DM + 1024 + h * 256 + 4 * lane) = w; }
            if (BOTH(pb + 2) || (rep_ == 0 && (PROBE_DUP) == 2)) GRID_BAR();
        }

        if (IN(pb + 3)) REPS(3) {
            PHASE_LOCALS
            FILL_STATIC(M, DM);
            pg8::Gemm g{MRG, WO_T + (size_t)l * DM * DM, DM}; pg8::TabOrder S{((LAS int*)(lds + T_MISC))[1], utab, rowtab};
            pg8::EpiRes E{XB, QBUF, ALPHA};
            pg8::gemm_phase<pg8::EpiRes, pg8::TabOrder, false>(lds, g, S, E);
            if (BOTH(pb + 3) || (rep_ == 0 && (PROBE_DUP) == 3)) GRID_BAR();
        }

        if (IN(pb + 4)) {
            PHASE_LOCALS
            LAS float* gl = (LAS float*)lds; LAS float* bl = (LAS float*)(lds + 8192);
            LAS float* part = (LAS float*)(lds + 16384); LAS float* logits = (LAS float*)(lds + 114688);
            LAS int* hist = (LAS int*)(lds + T_HIST); LAS int* basee = (LAS int*)(lds + T_BASE);
            for (int i = tid; i < DM; i += 512) { gl[i] = args.in[I_LN1G][l * DM + i]; bl[i] = args.in[I_LN1B][l * DM + i]; }
            __syncthreads();
            for (int tile = bx; tile < M / 64; tile += G) {
                for (int rr = 0; rr < 8; ++rr) { const int row = tile * 64 + wave * 8 + rr;
                    const GAS f32x4* xr = (const GAS f32x4*)(QBUF + (size_t)row * DM) + lane;
                    f32x4 v[8]; float s = 0.f;
#pragma unroll
                    for (int j = 0; j < 8; ++j) { v[j] = xr[64 * j]; s += (v[j][0] + v[j][1]) + (v[j][2] + v[j][3]); }
                    const float mean = wave_sum(s) * (1.f / DM); float s2 = 0.f;
#pragma unroll
                    for (int j = 0; j < 8; ++j) { v[j] = v[j] - mean; s2 += (v[j][0] * v[j][0] + v[j][1] * v[j][1]) + (v[j][2] * v[j][2] + v[j][3] * v[j][3]); }
                    const float rstd = 1.f / sqrtf(wave_sum(s2) * (1.f / DM) + LN_EPS);
                    GAS u32x2* o8 = (GAS u32x2*)(XB + (size_t)row * DM) + lane;
#pragma unroll
                    for (int j = 0; j < 8; ++j) { const f32x4 gg = *(const LAS f32x4*)(gl + 256 * j + 4 * lane), bb = *(const LAS f32x4*)(bl + 256 * j + 4 * lane);
                        const f32x4 y = v[j] * rstd * gg + bb;
                        u32x2 w; w.x = cvt_pk_bf16(y[0], y[1]); w.y = cvt_pk_bf16(y[2], y[3]); o8[64 * j] = w; }
                }
                if (tid < 32) hist[tid] = 0;
                VM_WAIT(); __syncthreads();
                skinny_logits<3>(XB + (size_t)tile * 64 * DM, WR_T + (size_t)l * 48 * DM, part, logits, tid);
                int e0 = 0, e1 = 0, lr0 = 0, lr1 = 0; float w0 = 0.f, w1 = 0.f;
                if (tid < 64) {
                    const LAS float* lg = logits + tid * 48;
                    float gv[4]; int gs = 0; float gm;
#pragma unroll
                    for (int q = 0; q < 4; ++q) gv[q] = lg[q] + args.in[I_BRG][l * 4 + q];
                    gm = gv[0];
#pragma unroll
                    for (int q = 1; q < 4; ++q) if (gv[q] > gm) { gm = gv[q]; gs = q; }
                    float gsum = 0.f;
#pragma unroll
                    for (int q = 0; q < 4; ++q) gsum += __expf(gv[q] - gm);
                    const float gw_ = 1.f / gsum;
                    float ev[8];
#pragma unroll
                    for (int q = 0; q < 8; ++q) ev[q] = lg[4 + gs * 8 + q] + args.in[I_BRE][l * 32 + gs * 8 + q];
                    int ia = 0; float va = ev[0];
#pragma unroll
                    for (int q = 1; q < 8; ++q) if (ev[q] > va) { va = ev[q]; ia = q; }
                    int ib = -1; float vb = -3.0e38f;
#pragma unroll
                    for (int q = 0; q < 8; ++q) if (q != ia && ev[q] > vb) { vb = ev[q]; ib = q; }
                    const float eb = __expf(vb - va), den = 1.f / (1.f + eb);
                    w0 = gw_ * den; w1 = gw_ * eb * den;
                    e0 = gs * 8 + ia; e1 = gs * 8 + ib;
                    lr0 = __hip_atomic_fetch_add(&hist[e0], 1, __ATOMIC_RELAXED, __HIP_MEMORY_SCOPE_WORKGROUP); lr1 = __hip_atomic_fetch_add(&hist[e1], 1, __ATOMIC_RELAXED, __HIP_MEMORY_SCOPE_WORKGROUP);
                }
                __syncthreads();
                if (tid < 32) { const int n = hist[tid]; int b0 = 0; if (n > 0) b0 = (int)__hip_atomic_fetch_add(cnt + tid * 16, (unsigned)n, RLX_AGENT); basee[tid] = b0; }
                __syncthreads();
                if (tid < 64) { const int token = tile * 64 + tid; const int r0 = basee[e0] + lr0, r1 = basee[e1] + lr1;
                    LIST[e0 * M + r0] = token; LIST[e1 * M + r1] = token;
                    u32x4 ta; ta.x = (unsigned)e0; ta.y = (unsigned)r0; ta.z = (unsigned)e1; ta.w = (unsigned)r1;
                    u32x4 tb; tb.x = __float_as_uint(w0); tb.y = __float_as_uint(w1); tb.z = 0u; tb.w = 0u;
                    *(GAS u32x4*)(TOK + (size_t)token * 8) = ta; *(GAS u32x4*)(TOK + (size_t)token * 8 + 4) = tb; }
                __syncthreads();
            }
            if (BOTH(pb + 4)) GRID_BAR();
        }

        if (IN(pb + 5) || IN(pb + 6)) REPS(5) {
            PHASE_LOCALS
            LAS int* chunk_e = (LAS int*)(lds + T_CHUNK_E); LAS int* tmisc = (LAS int*)(lds + T_MISC);
            LAS int* pstart = (LAS int*)(lds + T_PSTART);
            if (tid == 0) { int C = 0;
_Pragma("nounroll")
                for (int e = 0; e < NE; ++e) { const int n = (int)__hip_atomic_load(cnt + e * 16, RLX_AGENT); const int nch = (n + 255) >> 8; pstart[e] = C;
_Pragma("nounroll")
                    for (int c = 0; c < nch; ++c) chunk_e[C + c] = e; C += nch; } tmisc[0] = C; }
            __syncthreads();
            const int C = tmisc[0];
            if (IN(pb + 5)) {
                FILL_GROUPED(C * 4, 2);
                const int nu = tmisc[1];
_Pragma("nounroll")
                for (int i = 0; i < nu; ++i) { const int pm_ = utab[2 * i], e = utab[2 * i + 1] >> 2, r0 = (pm_ - pstart[e]) * 256; const int n = (int)__hip_atomic_load(cnt + e * 16, RLX_AGENT);
                    for (int r = tid; r < 256; r += 512) { const int rk = (r0 + r < n) ? r0 + r : r0; rowtab[i * 256 + r] = (unsigned)LIST[e * M + rk] * (unsigned)(DM * 2); } }
                __syncthreads();
                pg8::TabOrder S{nu, utab, rowtab};
                pg8::Gemm g{XB, WGU_T + (size_t)l * NE * 1024 * DM, DM};
                pg8::EpiSwiGLU E{HID};
                pg8::gemm_phase<pg8::EpiSwiGLU, pg8::TabOrder, true>(lds, g, S, E);
                if (BOTH(pb + 5)) GRID_BAR();
            }
            if (IN(pb + 6)) {
                FILL_GROUPED(C * 8, 3);
                pg8::TabOrder S{tmisc[1], utab, rowtab};
                pg8::Gemm g{HID, WD_T + (size_t)l * NE * DM * DE, DE};
                pg8::EpiDown E{YS};
                pg8::gemm_phase<pg8::EpiDown, pg8::TabOrder, false>(lds, g, S, E);
                if (BOTH(pb + 6) || (rep_ == 0 && (PROBE_DUP) == 5)) GRID_BAR();
            }
        }

        if (IN(pb + 7)) REPS(7) {
            PHASE_LOCALS
            LAS float* gl = (LAS float*)lds; LAS float* bl = (LAS float*)(lds + 8192); LAS int* pstart = (LAS int*)(lds + T_PSTART);
            for (int i = tid; i < DM; i += 512) { gl[i] = args.in[I_LN2G][l * DM + i]; bl[i] = args.in[I_LN2B][l * DM + i]; }
            if (tid == 0) { int C = 0;
_Pragma("nounroll")
                for (int e = 0; e < NE; ++e) { const int n = (int)__hip_atomic_load(cnt + e * 16, RLX_AGENT); pstart[e] = C * 256; C += (n + 255) >> 8; } }
            __syncthreads();
            const int gw = vcu * 8 + wave, NGW = G * 8;
            for (int row = gw; row < M; row += NGW) {
                const u32x4 ta = *(const GAS u32x4*)(TOK + (size_t)row * 8); const u32x2 tb = *(const GAS u32x2*)(TOK + (size_t)row * 8 + 4);
                const int s0 = pstart[ta.x] + (int)ta.y, s1 = pstart[ta.z] + (int)ta.w; const float w0 = __uint_as_float(tb.x), w1 = __uint_as_float(tb.y);
                const GAS u32x2* xr = (const GAS u32x2*)(XB + (size_t)row * DM) + lane;
                const GAS u32x2* y0 = (const GAS u32x2*)(YS + (size_t)s0 * DM) + lane; const GAS u32x2* y1 = (const GAS u32x2*)(YS + (size_t)s1 * DM) + lane;
                f32x4 v[8]; float s = 0.f;
#pragma unroll
                for (int j = 0; j < 8; ++j) { const u32x2 xq = xr[64 * j]; const f32x4 xx = (f32x4){bf_lo(xq.x), bf_hi(xq.x), bf_lo(xq.y), bf_hi(xq.y)}; const u32x2 a = y0[64 * j], b = y1[64 * j];
                    f32x4 t; t[0] = xx[0] * ALPHA + (w0 * bf_lo(a.x) + w1 * bf_lo(b.x)); t[1] = xx[1] * ALPHA + (w0 * bf_hi(a.x) + w1 * bf_hi(b.x));
                    t[2] = xx[2] * ALPHA + (w0 * bf_lo(a.y) + w1 * bf_lo(b.y)); t[3] = xx[3] * ALPHA + (w0 * bf_hi(a.y) + w1 * bf_hi(b.y));
                    v[j] = t; s += (t[0] + t[1]) + (t[2] + t[3]); }
                const float mean = wave_sum(s) * (1.f / DM); float s2 = 0.f;
#pragma unroll
                for (int j = 0; j < 8; ++j) { v[j] = v[j] - mean; s2 += (v[j][0] * v[j][0] + v[j][1] * v[j][1]) + (v[j][2] * v[j][2] + v[j][3] * v[j][3]); }
                const float rstd = 1.f / sqrtf(wave_sum(s2) * (1.f / DM) + LN_EPS);
                GAS f32x4* po = (GAS f32x4*)(args.out + (size_t)row * DM) + lane; GAS u32x2* o8 = (GAS u32x2*)(XB + (size_t)row * DM) + lane; const bool lastl = (l == DEPTH - 1);
#pragma unroll
                for (int j = 0; j < 8; ++j) { const f32x4 gg = *(const LAS f32x4*)(gl + 256 * j + 4 * lane), bb = *(const LAS f32x4*)(bl + 256 * j + 4 * lane);
                    const f32x4 y = v[j] * rstd * gg + bb;
                    if (lastl) po[64 * j] = y;
                    else { u32x2 w; w.x = cvt_pk_bf16(y[0], y[1]); w.y = cvt_pk_bf16(y[2], y[3]); o8[64 * j] = w; } }
            }
            if (BOTH(pb + 7) || (rep_ == 0 && (PROBE_DUP) == 7)) GRID_BAR();
        }
    }
#undef IN
#undef BOTH
#undef GRID_BAR
}

extern "C" void kernel_launch(void* const* d_in, const int* in_sizes, int n_in, void* d_out, int out_size, void* d_ws, size_t ws_size, hipStream_t stream) {
    static int grid = 0;
    if (grid == 0) {
        if (n_in != 17 || in_sizes[0] != M * DM || out_size != M * DM || ws_size < WS_END) { fprintf(stderr, "kernel_launch: unexpected shapes (n_in %d in0 %d out %d ws %zu, need ws >= %zu); nothing launched\n", n_in, n_in > 0 ? in_sizes[0] : -1, out_size, ws_size, (size_t)WS_END); grid = -1; return; }
        int dev = 0, cus = 0, per_cu = 0;
        if (hipGetDevice(&dev) != hipSuccess || hipDeviceGetAttribute(&cus, hipDeviceAttributeMultiprocessorCount, dev) != hipSuccess) { grid = -1; return; }
        if (hipFuncSetAttribute((const void*)trunk_fwd, hipFuncAttributeMaxDynamicSharedMemorySize, LDS_BYTES) != hipSuccess) { fprintf(stderr, "kernel_launch: hipFuncSetAttribute failed\n"); grid = -1; return; }
        if (hipOccupancyMaxActiveBlocksPerMultiprocessor(&per_cu, (const void*)trunk_fwd, 512, LDS_BYTES) != hipSuccess || per_cu < 1) fprintf(stderr, "kernel_launch: occupancy query reports %d\n", per_cu);
        (void)hipGetLastError();
        grid = cus;
    }
    if (grid < 0) return;
    if (hipMemsetAsync((char*)d_ws + WS_CTL, 0, CTL_ZERO_BYTES, stream) != hipSuccess) return;
    Args a{};
    for (int i = 0; i < 17; ++i) a.in[i] = (const float*)d_in[i];
    a.out = (float*)d_out; a.ws = (unsigned char*)d_ws;
#if MK_PER_PHASE
    for (int ph = 0; ph < NPHASE; ++ph) { a.ph_lo = ph; a.ph_hi = ph + 1; hipLaunchKernelGGL(trunk_fwd, dim3(grid), dim3(512), LDS_BYTES, stream, a); }
#else
    a.ph_lo = 0; a.ph_hi = NPHASE; hipLaunchKernelGGL(trunk_fwd, dim3(grid), dim3(512), LDS_BYTES, stream, a);
#endif
}
```
